# Optimizing an MI355X kernel written in HIP

```python
import math
import jax
import jax.numpy as jnp
from jax import lax
import numpy as np

D_MODEL = 2048
BATCH = 4
SEQ = 2048
DEPTH = 1
DEC_BATCH = 8
DEC_SEQ = 64
PAST_LEN = 1024

CHUNK = 64
EPS = 1e-6
NEG_INF = -1e30
Q_BLOCK = 128
DA_HEADS = 8
DA_QK_DIM = 64
DA_V_DIM = 2 * DA_QK_DIM
DA_WIDTH = DA_HEADS * DA_V_DIM
ROPE_DIM = DA_QK_DIM // 4
ROPE_THETA = 500000.0
CM_GROUPS = 4
CM_GROUP_DIM = 128
CM_WIDTH = CM_GROUPS * CM_GROUP_DIM
CM_LEN = 128
MEM_TOKENS = 256
MEM_HEADS = 4
MEM_HEAD_DIM = 128
MEM_WIDTH = MEM_HEADS * MEM_HEAD_DIM
N_BRANCH = 3
MIX_WIDTH = DA_WIDTH + CM_WIDTH + MEM_WIDTH
IN_SPLITS = (DA_WIDTH, 2 * DA_WIDTH, 3 * DA_WIDTH, 3 * DA_WIDTH + CM_WIDTH, 3 * DA_WIDTH + 2 * CM_WIDTH, 3 * DA_WIDTH + 2 * CM_WIDTH + MEM_WIDTH)
IN_WIDTH = 3 * DA_WIDTH + 2 * CM_WIDTH + MEM_WIDTH + N_BRANCH * D_MODEL
PEER_HEADS = 8
PEER_NKEYS = 128
PEER_EXPERTS = PEER_NKEYS * PEER_NKEYS
PEER_QDIM = 256
PEER_HALF = PEER_QDIM // 2
PEER_TOPK = 16
PEER_TOKEN_BLOCK = 128

kernel_name = 'streaming_hybrid_diffattn_gmlp_mem_peer'


def rms_norm(x, g):
    xf = x.astype(jnp.float32)
    y = xf * lax.rsqrt(jnp.mean(xf * xf, axis=-1, keepdims=True) + EPS)
    return (y * g.astype(jnp.float32)).astype(x.dtype)


def layer_norm(x, g, b):
    xf = x.astype(jnp.float32)
    mu = jnp.mean(xf, axis=-1, keepdims=True)
    xc = xf - mu
    var = jnp.mean(xc * xc, axis=-1, keepdims=True)
    return (xc * lax.rsqrt(var + EPS) * g.astype(jnp.float32) + b.astype(jnp.float32)).astype(x.dtype)


def rope_partial(x, pos):
    half = ROPE_DIM // 2
    inv = ROPE_THETA ** (-jnp.arange(half, dtype=jnp.float32) / half)
    ang = pos.astype(jnp.float32)[:, None] * inv[None, :]
    cos = jnp.cos(ang)[:, None, None, :]
    sin = jnp.sin(ang)[:, None, None, :]
    xr = x[..., :ROPE_DIM].astype(jnp.float32)
    x1, x2 = xr[..., :half], xr[..., half:]
    rot = jnp.concatenate([x1 * cos - x2 * sin, x2 * cos + x1 * sin], axis=-1)
    return jnp.concatenate([rot.astype(x.dtype), x[..., ROPE_DIM:]], axis=-1)


def diff_attend(q, k, v, q_pos, k_pos, lam):
    s = jnp.einsum('bqhmd,bkhmd->bhmqk', q, k).astype(jnp.float32) * (DA_QK_DIM ** -0.5)
    mask = (k_pos[None, :] // CHUNK) <= (q_pos[:, None] // CHUNK)
    s = jnp.where(mask, s, NEG_INF)
    p = jax.nn.softmax(s, axis=-1)
    a = p[:, :, 0] - lam * p[:, :, 1]
    return jnp.einsum('bhqk,bkhd->bqhd', a.astype(v.dtype), v)


def diff_attention_blocked(q, k, v, pos, lam):
    B, T = q.shape[0], q.shape[1]
    nb = T // Q_BLOCK
    qb = jnp.moveaxis(q.reshape(B, nb, Q_BLOCK, DA_HEADS, 2, DA_QK_DIM), 1, 0)
    pb = pos.reshape(nb, Q_BLOCK)
    ob = lax.map(lambda a: diff_attend(a[0], k, v, a[1], pos, lam), (qb, pb))
    return jnp.moveaxis(ob, 0, 1).reshape(B, T, DA_HEADS, DA_V_DIM)


def chunk_mlp(u, v, w_s, b_s):
    B, T, _ = u.shape
    L = min(T, CM_LEN)
    nc = T // L
    ws = jnp.tril(w_s[:, :L, :L])
    vb = v.reshape(B, nc, L, CM_GROUPS, CM_GROUP_DIM)
    s = jnp.einsum('gts,bnsgc->bntgc', ws, vb) + jnp.transpose(b_s[:, :L])[None, None, :, :, None]
    return u * s.reshape(B, T, CM_WIDTH)


def mem_kv(mem, g, w, kn_g):
    B, M, _ = mem.shape
    kv = rms_norm(mem, g) @ w
    k, v = jnp.split(kv, 2, axis=-1)
    k = rms_norm(k.reshape(B, M, MEM_HEADS, MEM_HEAD_DIM), kn_g)
    return k, v.reshape(B, M, MEM_HEADS, MEM_HEAD_DIM)


def mem_attend(q, mem_k, mem_v):
    s = jnp.einsum('bqhd,bkhd->bhqk', q, mem_k).astype(jnp.float32) * (MEM_HEAD_DIM ** -0.5)
    p = jax.nn.softmax(s, axis=-1).astype(mem_v.dtype)
    return jnp.einsum('bhqk,bkhd->bqhd', p, mem_v)


def _peer_block(xb, w_query, sub_keys, expert_u, expert_v):
    tb = xb.shape[0]
    q = (xb @ w_query).reshape(tb, PEER_HEADS, 2, PEER_HALF)
    s = jnp.einsum('thpc,hpkc->thpk', q, sub_keys).astype(jnp.float32)
    s1, i1 = lax.top_k(s[:, :, 0], PEER_TOPK)
    s2, i2 = lax.top_k(s[:, :, 1], PEER_TOPK)
    n_cand = PEER_TOPK * PEER_TOPK
    cand_s = (s1[..., :, None] + s2[..., None, :]).reshape(tb, PEER_HEADS, n_cand)
    cand_i = (i1[..., :, None] * PEER_NKEYS + i2[..., None, :]).reshape(tb, PEER_HEADS, n_cand)
    top_s, top_j = lax.top_k(cand_s, PEER_TOPK)
    eidx = jnp.take_along_axis(cand_i, top_j, axis=-1)
    g = jax.nn.softmax(top_s, axis=-1).astype(xb.dtype)
    a = jax.nn.gelu(jnp.einsum('td,thkd->thk', xb, expert_u[eidx]), approximate=False)
    return jnp.einsum('thk,thkd->td', g * a, expert_v[eidx])


def peer(x, w_query, sub_keys, expert_u, expert_v):
    B, T, D = x.shape
    n = B * T
    pad = (-n) % PEER_TOKEN_BLOCK
    xf = jnp.pad(x.reshape(n, D), ((0, pad), (0, 0)))
    out = lax.map(lambda xb: _peer_block(xb, w_query, sub_keys, expert_u, expert_v), xf.reshape(-1, PEER_TOKEN_BLOCK, D))
    return out.reshape(-1, D)[:n].reshape(B, T, D)


def setup_inputs(seed: int = 0) -> dict:
    key = jax.random.key(seed)
    ks = jax.random.split(key, 32)
    f32 = jnp.float32

    def nrm(k, shape, scale):
        return jax.random.normal(k, shape, f32) * scale

    def gain(k, shape):
        return 1.0 + 0.01 * jax.random.normal(k, shape, f32)

    L = DEPTH
    return {
        'x_prompt': nrm(ks[0], (BATCH, SEQ, D_MODEL), 1.0),
        'x_sample': nrm(ks[1], (DEC_BATCH, DEC_SEQ, D_MODEL), 1.0),
        'mem_prompt': nrm(ks[2], (BATCH, MEM_TOKENS, D_MODEL), 1.0),
        'cache_da_k': nrm(ks[3], (L, DEC_BATCH, PAST_LEN, DA_HEADS, 2 * DA_QK_DIM), 1.0),
        'cache_da_v': nrm(ks[4], (L, DEC_BATCH, PAST_LEN, DA_HEADS, DA_V_DIM), 1.0),
        'cache_mem_k': nrm(ks[5], (L, DEC_BATCH, MEM_TOKENS, MEM_HEADS, MEM_HEAD_DIM), 1.0),
        'cache_mem_v': nrm(ks[6], (L, DEC_BATCH, MEM_TOKENS, MEM_HEADS, MEM_HEAD_DIM), 1.0),
        'norm_mix_g': gain(ks[7], (L, D_MODEL)),
        'w_in': nrm(ks[8], (L, D_MODEL, IN_WIDTH), D_MODEL ** -0.5),
        'b_gate': nrm(ks[9], (L, N_BRANCH * D_MODEL), 0.01),
        'da_qn_g': gain(ks[10], (L, DA_QK_DIM)),
        'da_kn_g': gain(ks[11], (L, DA_QK_DIM)),
        'da_lambda_q1': nrm(ks[12], (L, DA_QK_DIM), 0.1),
        'da_lambda_k1': nrm(ks[13], (L, DA_QK_DIM), 0.1),
        'da_lambda_q2': nrm(ks[14], (L, DA_QK_DIM), 0.1),
        'da_lambda_k2': nrm(ks[15], (L, DA_QK_DIM), 0.1),
        'da_out_g': gain(ks[16], (L, DA_V_DIM)),
        'cm_ln_g': gain(ks[17], (L, CM_WIDTH)),
        'cm_ln_b': nrm(ks[18], (L, CM_WIDTH), 0.01),
        'cm_ws': nrm(ks[19], (L, CM_GROUPS, CM_LEN, CM_LEN), CM_LEN ** -0.5),
        'cm_bs': gain(ks[20], (L, CM_GROUPS, CM_LEN)),
        'norm_mem_g': gain(ks[21], (L, D_MODEL)),
        'w_mem_kv': nrm(ks[22], (L, D_MODEL, 2 * MEM_WIDTH), D_MODEL ** -0.5),
        'mem_qn_g': gain(ks[23], (L, MEM_HEAD_DIM)),
        'mem_kn_g': gain(ks[24], (L, MEM_HEAD_DIM)),
        'w_branch': nrm(ks[25], (L, MIX_WIDTH, D_MODEL), MIX_WIDTH ** -0.5),
        'w_out': nrm(ks[26], (L, D_MODEL, D_MODEL), D_MODEL ** -0.5),
        'norm_ffn_g': gain(ks[27], (L, D_MODEL)),
        'peer_w_query': nrm(ks[28], (L, D_MODEL, PEER_HEADS * PEER_QDIM), D_MODEL ** -0.5),
        'peer_sub_keys': nrm(ks[29], (L, PEER_HEADS, 2, PEER_NKEYS, PEER_HALF), PEER_HALF ** -0.5),
        'peer_u': nrm(ks[30], (L, PEER_EXPERTS, D_MODEL), D_MODEL ** -0.5),
        'peer_v': nrm(ks[31], (L, PEER_EXPERTS, D_MODEL), (PEER_HEADS * PEER_TOPK) ** -0.5),
    }


def reference(x_prompt, x_sample, mem_prompt, cache_da_k, cache_da_v, cache_mem_k, cache_mem_v,
              norm_mix_g, w_in, b_gate, da_qn_g, da_kn_g, da_lambda_q1, da_lambda_k1,
              da_lambda_q2, da_lambda_k2, da_out_g, cm_ln_g, cm_ln_b, cm_ws, cm_bs,
              norm_mem_g, w_mem_kv, mem_qn_g, mem_kn_g, w_branch, w_out, norm_ffn_g,
              peer_w_query, peer_sub_keys, peer_u, peer_v):
    f32 = jnp.float32

    def mix_layer(l, x, pos, past_k, past_v, mem_k, mem_v):
        B, T, _ = x.shape
        lam_init = 0.8 - 0.6 * math.exp(-0.3 * l)
        lam = (jnp.exp(jnp.sum(da_lambda_q1[l].astype(f32) * da_lambda_k1[l].astype(f32)))
               - jnp.exp(jnp.sum(da_lambda_q2[l].astype(f32) * da_lambda_k2[l].astype(f32))) + lam_init)
        h = rms_norm(x, norm_mix_g[l])
        p = h @ w_in[l]
        q_da, k_da, v_da, u_cm, v_cm, q_mem, g_logit = jnp.split(p, list(IN_SPLITS), axis=-1)
        q = rope_partial(rms_norm(q_da.reshape(B, T, DA_HEADS, 2, DA_QK_DIM), da_qn_g[l]), pos)
        k = rope_partial(rms_norm(k_da.reshape(B, T, DA_HEADS, 2, DA_QK_DIM), da_kn_g[l]), pos)
        v = v_da.reshape(B, T, DA_HEADS, DA_V_DIM)
        if past_k is None:
            o = diff_attention_blocked(q, k, v, pos, lam)
        else:
            P = past_k.shape[1]
            k_all = jnp.concatenate([past_k.reshape(B, P, DA_HEADS, 2, DA_QK_DIM), k], axis=1)
            v_all = jnp.concatenate([past_v, v], axis=1)
            o = diff_attend(q, k_all, v_all, pos, jnp.arange(P + T), lam)
        o_da = (rms_norm(o, da_out_g[l]) * (1.0 - lam_init)).reshape(B, T, DA_WIDTH)
        u = jax.nn.gelu(u_cm, approximate=False)
        vn = layer_norm(jax.nn.gelu(v_cm, approximate=False), cm_ln_g[l], cm_ln_b[l])
        o_cm = chunk_mlp(u, vn, cm_ws[l], cm_bs[l])
        qm = rms_norm(q_mem.reshape(B, T, MEM_HEADS, MEM_HEAD_DIM), mem_qn_g[l])
        o_mem = mem_attend(qm, mem_k, mem_v).reshape(B, T, MEM_WIDTH)
        wb = w_branch[l]
        gates = jax.nn.sigmoid(g_logit.reshape(B, T, N_BRANCH, D_MODEL) + b_gate[l].reshape(N_BRANCH, D_MODEL))
        merged = (gates[:, :, 0] * (o_da @ wb[:DA_WIDTH])
                  + gates[:, :, 1] * (o_cm @ wb[DA_WIDTH:DA_WIDTH + CM_WIDTH])
                  + gates[:, :, 2] * (o_mem @ wb[DA_WIDTH + CM_WIDTH:]))
        x = x + merged @ w_out[l]
        x = x + peer(rms_norm(x, norm_ffn_g[l]), peer_w_query[l], peer_sub_keys[l], peer_u[l], peer_v[l])
        return x, k.reshape(B, T, DA_HEADS, 2 * DA_QK_DIM), v, vn

    pos_p = jnp.arange(x_prompt.shape[1])
    pos_s = cache_da_k.shape[2] + jnp.arange(x_sample.shape[1])
    yp, ys = x_prompt, x_sample
    kp_l, vp_l, mkp_l, mvp_l, ks_l, vs_l, cvs_l = [], [], [], [], [], [], []
    for l in range(DEPTH):
        mk, mv = mem_kv(mem_prompt, norm_mem_g[l], w_mem_kv[l], mem_kn_g[l])
        yp, kp, vp, _ = mix_layer(l, yp, pos_p, None, None, mk, mv)
        ys, ks, vs, cvs = mix_layer(l, ys, pos_s, cache_da_k[l], cache_da_v[l], cache_mem_k[l], cache_mem_v[l])
        kp_l.append(kp)
        vp_l.append(vp)
        mkp_l.append(mk)
        mvp_l.append(mv)
        ks_l.append(ks)
        vs_l.append(vs)
        cvs_l.append(cvs)
    new_da_k_prompt = jnp.stack(kp_l)
    new_da_v_prompt = jnp.stack(vp_l)
    new_mem_k_prompt = jnp.stack(mkp_l)
    new_mem_v_prompt = jnp.stack(mvp_l)
    new_da_k_sample = jnp.stack(ks_l)
    new_da_v_sample = jnp.stack(vs_l)
    new_cm_v_sample = jnp.stack(cvs_l)
    return (yp, ys, new_da_k_prompt, new_da_v_prompt, new_mem_k_prompt, new_mem_v_prompt, new_da_k_sample, new_da_v_sample, new_cm_v_sample)
```

```cpp
#include <hip/hip_runtime.h>
#include <hip/hip_cooperative_groups.h>
#include <cstdint>
#include <cstdio>
namespace cg = cooperative_groups;

#define DI __device__ __forceinline__
typedef unsigned short bf16_t;
typedef short bf16x8 __attribute__((ext_vector_type(8)));
typedef short s16x4 __attribute__((ext_vector_type(4)));
typedef float f32x16 __attribute__((ext_vector_type(16)));
typedef float f32x4 __attribute__((ext_vector_type(4)));
typedef float f32x2 __attribute__((ext_vector_type(2)));
typedef unsigned u32x4 __attribute__((ext_vector_type(4)));
typedef unsigned u32x2 __attribute__((ext_vector_type(2)));
typedef __bf16 bf16v2 __attribute__((ext_vector_type(2)));
#define LDS3 __attribute__((address_space(3)))

constexpr int D = 2048, NP = 8192, NS = 512, MT = 8704, INW = 10752;
constexpr int OFF_Q = 0, OFF_K = 1024, OFF_V = 2048, OFF_U = 3072, OFF_VC = 3584, OFF_QM = 4096, OFF_G = 4608;
constexpr float EPS = 1e-6f;
constexpr float LOG2E = 1.4426950408889634f;
constexpr size_t O_Y = 0, O_KP = 17825792, O_VP = 26214400, O_MKP = 34603008, O_MVP = 35127296, O_KS = 35651584, O_VS = 36175872, O_CVS = 36700160;
constexpr size_t WS_CTL = 0;
constexpr size_t WS_BAR = 4096;
constexpr size_t WS_UB = 32768;
constexpr size_t WS_VB = WS_UB + 67108864;
constexpr size_t WS_P = WS_VB + 67108864;
constexpr size_t WS_WINT = WS_P + 187170816;
constexpr size_t WS_HB = WS_WINT + 44040192;
constexpr size_t WS_WMEMT = WS_HB + 35651584;
constexpr size_t WS_WBT = WS_WMEMT + 4194304;
constexpr size_t WS_WOT = WS_WBT + 8388608;
constexpr size_t WS_WQT = WS_WOT + 8388608;
constexpr size_t WS_MEMHB = WS_WQT + 8388608;
constexpr size_t WS_SKB = WS_MEMHB + 4194304;
constexpr size_t WS_KS = WS_SKB + 524288;
constexpr size_t WS_VS = WS_KS + 17825792;
constexpr size_t WS_MEMKV = WS_VS + 17825792;
constexpr size_t WS_MEMKB = WS_MEMKV + 4194304;
constexpr size_t WS_MEMVB = WS_MEMKB + 1048576;
constexpr size_t WS_CMK = WS_MEMVB + 1048576;
constexpr size_t WS_CMV = WS_CMK + 2097152;
constexpr size_t WS_VSC = WS_CMV + 2097152;
constexpr size_t WS_USC = WS_VSC + 65536;
constexpr size_t WS_ROPE = WS_USC + 65536;
constexpr size_t WS_END = WS_ROPE + 2112 * 8 * 8;
constexpr size_t WS_MIXIN = WS_WINT;
constexpr size_t WS_MERGED = WS_HB;
constexpr size_t WS_X1G = WS_WINT;
constexpr size_t WS_PEERQ = WS_HB;
constexpr size_t WS_SCORES = WS_P;

constexpr int LDS_BYTES = 73728;

struct Params {
    const float* in[32];
    float* out;
    unsigned char* ws;
};
enum { I_XP = 0, I_XS, I_MEMP, I_CDK, I_CDV, I_CMK, I_CMV, I_NMIXG, I_WIN, I_BGATE, I_QNG, I_KNG, I_LQ1, I_LK1, I_LQ2, I_LK2, I_OUTG,
       I_CMLNG, I_CMLNB, I_CMWS, I_CMBS, I_NMEMG, I_WMEMKV, I_MQNG, I_MKNG, I_WBR, I_WOUT, I_NFFNG, I_PWQ, I_PSK, I_PU, I_PV };

DI unsigned pk2(float lo, float hi) { f32x2 f = {lo, hi}; bf16v2 b = __builtin_convertvector(f, bf16v2); return __builtin_bit_cast(unsigned, b); }
DI bf16_t f2bf(float x) { return (bf16_t)(pk2(x, 0.f) & 0xffffu); }
DI float bflo(unsigned u) { return __uint_as_float(u << 16); }
DI float bfhi(unsigned u) { return __uint_as_float(u & 0xffff0000u); }
DI float bf2f(bf16_t b) { return __uint_as_float(((unsigned)b) << 16); }
DI void unpack8(u32x4 v, float* f) { f[0] = bflo(v.x); f[1] = bfhi(v.x); f[2] = bflo(v.y); f[3] = bfhi(v.y); f[4] = bflo(v.z); f[5] = bfhi(v.z); f[6] = bflo(v.w); f[7] = bfhi(v.w); }
DI u32x4 pack8(const float* f) { u32x4 r; r.x = pk2(f[0], f[1]); r.y = pk2(f[2], f[3]); r.z = pk2(f[4], f[5]); r.w = pk2(f[6], f[7]); return r; }
DI int shx(int v, int j) {
    switch (j) {
        case 1: return __builtin_amdgcn_update_dpp(0, v, 0xB1, 0xF, 0xF, true);
        case 2: return __builtin_amdgcn_update_dpp(0, v, 0x4E, 0xF, 0xF, true);
        case 4: return __builtin_amdgcn_update_dpp(0, __builtin_amdgcn_update_dpp(0, v, 0x141, 0xF, 0xF, true), 0x1B, 0xF, 0xF, true);
        case 8: return __builtin_amdgcn_update_dpp(0, v, 0x128, 0xF, 0xF, true);
        case 16: { const u32x2 r = __builtin_amdgcn_permlane16_swap((unsigned)v, (unsigned)v, false, false); return (threadIdx.x & 16) ? (int)r[0] : (int)r[1]; }
        default: { const u32x2 r = __builtin_amdgcn_permlane32_swap((unsigned)v, (unsigned)v, false, false); return (threadIdx.x & 32) ? (int)r[0] : (int)r[1]; }
    }
}
DI float shxf(float v, int j) { return __int_as_float(shx(__float_as_int(v), j)); }
DI float wave_sum(float v) {
#pragma unroll
    for (int o = 32; o > 0; o >>= 1) v += shxf(v, o);
    return v;
}
DI int opaque_tid() { int t = threadIdx.x; asm volatile("" : "+v"(t)); return t; }
DI int crow(int i, int h) { return (i & 3) + 8 * (i >> 2) + 4 * h; }
DI float gelu_exact(float x) { return 0.5f * x * (1.0f + erff(x * 0.70710678118654752f)); }
DI float gelu_fast(float v) {
    const float av = fabsf(v), t = __builtin_amdgcn_rcpf(av * 0.2316418882f + 1.0f);
    float q = t * 0.5307027145f + (-0.7265760135f); q = q * t + 0.7107068705f; q = q * t + (-0.142248368f); q = q * t + 0.127414796f; q = q * t;
    const float e = __builtin_amdgcn_exp2f((v * v) * (-0.72134752044f));
    const float m = v * (q * e);
    return v < 0.f ? m : v - m;
}
#define MFMA32(a, b, c) __builtin_amdgcn_mfma_f32_32x32x16_bf16((a), (b), (c), 0, 0, 0)
DI f32x16 zero16() { f32x16 z; for (int i = 0; i < 16; ++i) z[i] = 0.f; return z; }
DI bf16x8 tr_pair(const unsigned char* lo, const unsigned char* hi) {
    s16x4 a = __builtin_amdgcn_ds_read_tr16_b64_v4i16((LDS3 s16x4*)lo);
    s16x4 b = __builtin_amdgcn_ds_read_tr16_b64_v4i16((LDS3 s16x4*)hi);
    return __builtin_shufflevector(a, b, 0, 1, 2, 3, 4, 5, 6, 7);
}

#define SGPR(x) __builtin_amdgcn_readfirstlane(x)
template <class F> DI void for_tiles(int TM, int TN, F f) {
    const int T = TM * TN, G = gridDim.x, bid = blockIdx.x;
    const int nx = (G % 8 == 0) ? 8 : 1;
    const int xcd = SGPR(bid % nx), idx = SGPR(bid / nx), per = SGPR(G / nx);
    const int chunk = SGPR((T + nx - 1) / nx);
    for (int v = idx; v < chunk; v += per) {
        const int id = xcd * chunk + v;
        if (id >= T) break;
        const int gsize = 8 * TN, g = SGPR(id / gsize), rem = id - g * gsize;
        const int mrows = (TM - 8 * g) < 8 ? (TM - 8 * g) : 8;
        const int tn = SGPR(rem / mrows), tm = 8 * g + (rem - tn * mrows);
        f(tm, tn);
    }
}

#define GLB1 __attribute__((address_space(1)))
template <int N> DI void wait_vm() {
    if constexpr (N == 0) asm volatile("s_waitcnt vmcnt(0)" ::: "memory");
    else if constexpr (N == 3) asm volatile("s_waitcnt vmcnt(3)" ::: "memory");
    else if constexpr (N == 4) asm volatile("s_waitcnt vmcnt(4)" ::: "memory");
    else if constexpr (N == 6) asm volatile("s_waitcnt vmcnt(6)" ::: "memory");
    else if constexpr (N == 8) asm volatile("s_waitcnt vmcnt(8)" ::: "memory");
    else if constexpr (N == 12) asm volatile("s_waitcnt vmcnt(12)" ::: "memory");
    else if constexpr (N == 16) asm volatile("s_waitcnt vmcnt(16)" ::: "memory");
    else static_assert(N == 0, "add the count");
}
template <int MI, int NST>
DI void gemm_kloop(f32x16 (&acc)[MI][2], const bf16_t* __restrict__ Ag, int lda, const bf16_t* __restrict__ Bg, int ldb, int nk  , unsigned char* smem) {
    constexpr int AROWS = 64 * MI, A_BYTES = AROWS * 64, STAGE = A_BYTES + 128 * 64, AL = MI  , BL = 2, LPW = AL + BL;
    static_assert(NST >= 3 && NST * STAGE <= 73728, "ring does not fit");
    const int tid = opaque_tid(), lane = tid & 63, wave = tid >> 6, wm = wave >> 1, wn = wave & 1, r = lane & 31, h = lane >> 5;
    const int frow = lane >> 2, fslot = lane & 3;
    const int kcs = (fslot ^ ((frow >> 2) & 3)) * 8;
    const int aoff0 = (wave * AL * 16 + frow) * lda + kcs, boff0 = (wave * BL * 16 + frow) * ldb + kcs;
    unsigned char* afill = smem + wave * AL * 1024;
    unsigned char* bfill = smem + A_BYTES + wave * BL * 1024;
#define GEMM_FILL(slot_, kt_)                                                                                                        \
    {                                                                                                                                \
        _Pragma("unroll") for (int i = 0; i < AL; ++i)                                                                               \
            __builtin_amdgcn_global_load_lds((GLB1 const void*)(Ag + (size_t)(i * 16) * lda + (kt_) * 32 + aoff0), (LDS3 void*)(afill + (slot_) * STAGE + i * 1024), 16, 0, 0); \
        _Pragma("unroll") for (int i = 0; i < BL; ++i)                                                                               \
            __builtin_amdgcn_global_load_lds((GLB1 const void*)(Bg + (size_t)(i * 16) * ldb + (kt_) * 32 + boff0), (LDS3 void*)(bfill + (slot_) * STAGE + i * 1024), 16, 0, 0); \
    }
#pragma unroll
    for (int t = 0; t < NST - 1; ++t) GEMM_FILL(t, t)
    const int sw = (r >> 2) & 3;
    const int k0off = ((0 + h) ^ sw) * 16, k1off = ((2 + h) ^ sw) * 16;
    const int a_rd = (wm * 32 * MI + r) * 64;
    const int b_rd = A_BYTES + (wn * 64 + r) * 64;
    int slot = 0;
    for (int kt = 0; kt < nk; ++kt) {
        const int rem = nk - 1 - kt;
        if (rem >= NST - 2) wait_vm<(NST - 2) * LPW>();
        else if (NST >= 4 && rem == 2) wait_vm<2 * LPW>();
        else if (rem == 1) wait_vm<LPW>();
        else wait_vm<0>();
        __builtin_amdgcn_s_barrier();
        asm volatile("" ::: "memory");
        if (kt + NST - 1 < nk) { const int fs = slot == 0 ? NST - 1 : slot - 1; GEMM_FILL(fs, kt + NST - 1) }
        const unsigned char* st = smem + slot * STAGE;
#pragma unroll
        for (int ks = 0; ks < 2; ++ks) {
            const int ko = ks == 0 ? k0off : k1off;
            bf16x8 b[2];
#pragma unroll
            for (int ni = 0; ni < 2; ++ni) b[ni] = *(const bf16x8*)(st + b_rd + ni * 32 * 64 + ko);
            constexpr int MS = MI >= 2 ? 2 : 1;
#pragma unroll
            for (int m0 = 0; m0 < MI; m0 += MS) {
                bf16x8 a[MS];
#pragma unroll
                for (int mi = 0; mi < MS; ++mi) a[mi] = *(const bf16x8*)(st + a_rd + (m0 + mi) * 32 * 64 + ko);
                __builtin_amdgcn_s_setprio(1);
#pragma unroll
                for (int mi = 0; mi < MS; ++mi)
#pragma unroll
                    for (int ni = 0; ni < 2; ++ni) acc[m0 + mi][ni] = MFMA32(a[mi], b[ni], acc[m0 + mi][ni]);
                __builtin_amdgcn_s_setprio(0);
            }
        }
        slot = slot + 1 == NST ? 0 : slot + 1;
    }
    __syncthreads();
#undef GEMM_FILL
}
#define EPI_FOR(MI_, acc_, BODY)                                                                             \
    {                                                                                                        \
        const int tid_ = opaque_tid(), lane_ = tid_ & 63, wave_ = tid_ >> 6, r_ = lane_ & 31, h_ = lane_ >> 5; \
        _Pragma("unroll") for (int mi_ = 0; mi_ < (MI_); ++mi_) _Pragma("unroll") for (int ni_ = 0; ni_ < 2; ++ni_) { \
            _Pragma("unroll") for (int i_ = 0; i_ < 16; ++i_) {                                              \
            const int row = (wave_ >> 1) * 32 * (MI_) + mi_ * 32 + crow(i_, h_);                             \
            const int col = (wave_ & 1) * 64 + ni_ * 32 + r_;                                                \
            const float v = acc_[mi_][ni_][i_];                                                              \
            BODY                                                                                             \
            if ((i_ & 3) == 3) asm volatile("" ::: "memory");     \
            }                                                                                                \
        }                                                                                                    \
    }

#define EPI_STORE_BF16(MI_, acc_, optr_, ld_)                                                                 \
    {                                                                                                        \
        const int tid_ = opaque_tid(), lane_ = tid_ & 63, wave_ = tid_ >> 6, r_ = lane_ & 31, h_ = lane_ >> 5; \
        const bool odd_ = (r_ & 1) != 0;                                                                     \
        _Pragma("unroll") for (int mi_ = 0; mi_ < (MI_); ++mi_) _Pragma("unroll") for (int ni_ = 0; ni_ < 2; ++ni_) \
            _Pragma("unroll") for (int i_ = 0; i_ < 16; i_ += 2) {                                           \
            const float a0_ = acc_[mi_][ni_][i_], a1_ = acc_[mi_][ni_][i_ + 1];                              \
            const float recv_ = shxf(odd_ ? a0_ : a1_, 1);                                                   \
            const int row_ = (wave_ >> 1) * 32 * (MI_) + mi_ * 32 + crow(i_ + (odd_ ? 1 : 0), h_);           \
            const int col_ = (wave_ & 1) * 64 + ni_ * 32 + (r_ & ~1);                                        \
            *(unsigned*)((optr_) + row_ * (ld_) + col_) = odd_ ? pk2(recv_, a1_) : pk2(a0_, recv_);          \
        }                                                                                                    \
    }

DI void rmsnorm_row_to_bf16(const float* x, const float* g, bf16_t* o, int lane) {
    f32x4 v[8], gq[8];
    float ss = 0.f;
#pragma unroll
    for (int c = 0; c < 8; ++c) { v[c] = *(const f32x4*)(x + c * 256 + lane * 4); gq[c] = *(const f32x4*)(g + c * 256 + lane * 4); }
#pragma unroll
    for (int c = 0; c < 8; ++c) ss += v[c][0] * v[c][0] + v[c][1] * v[c][1] + v[c][2] * v[c][2] + v[c][3] * v[c][3];
    ss = wave_sum(ss);
    const float rstd = rsqrtf(ss * (1.0f / 2048.0f) + EPS);
#pragma unroll
    for (int c = 0; c < 8; ++c) {
        const f32x4 gg = gq[c];
        u32x2 w; w.x = pk2(v[c][0] * rstd * gg[0], v[c][1] * rstd * gg[1]); w.y = pk2(v[c][2] * rstd * gg[2], v[c][3] * rstd * gg[3]);
        *(u32x2*)(o + c * 256 + lane * 4) = w;
    }
}
DI void transpose_tile(const float* W, int N, bf16_t* WT, int kt, int nt, unsigned char* smem) {
    float* tile = (float*)smem;
    const int tid = threadIdx.x;
#pragma unroll
    for (int i = 0; i < 4; ++i) {
        const int k = (tid >> 4) + 16 * i, n4 = (tid & 15) * 4;
        const f32x4 v = *(const f32x4*)(W + (size_t)(kt * 64 + k) * N + nt * 64 + n4);
        tile[k * 65 + n4 + 0] = v[0]; tile[k * 65 + n4 + 1] = v[1]; tile[k * 65 + n4 + 2] = v[2]; tile[k * 65 + n4 + 3] = v[3];
    }
    __syncthreads();
#pragma unroll
    for (int i = 0; i < 2; ++i) {
        const int n = (tid >> 3) + 32 * i, kc = (tid & 7) * 8;
        float f[8];
#pragma unroll
        for (int j = 0; j < 8; ++j) f[j] = tile[(kc + j) * 65 + n];
        *(u32x4*)(WT + (size_t)(nt * 64 + n) * 2048 + kt * 64 + kc) = pack8(f);
    }
    __syncthreads();
}
DI void convert_job(const float* src, bf16_t* dst, int job) {
    const int tid = threadIdx.x;
    f32x4 a[4], b[4];
#pragma unroll
    for (int i = 0; i < 4; ++i) { const size_t idx = (size_t)job * 8192 + i * 2048 + tid * 8; a[i] = *(const f32x4*)(src + idx); b[i] = *(const f32x4*)(src + idx + 4); }
#pragma unroll
    for (int i = 0; i < 4; ++i) {
        const size_t idx = (size_t)job * 8192 + i * 2048 + tid * 8;
        u32x4 w; w.x = pk2(a[i][0], a[i][1]); w.y = pk2(a[i][2], a[i][3]); w.z = pk2(b[i][0], b[i][1]); w.w = pk2(b[i][2], b[i][3]);
        *(u32x4*)(dst + idx) = w;
    }
}
DI void convert8_job(const float* src, unsigned char* dst, int job, float scale) {
    const int tid = threadIdx.x;
#pragma unroll
    for (int i = 0; i < 2; ++i) {
        const size_t idx = (size_t)job * 8192 + i * 4096 + tid * 16;
        u32x4 w;
#pragma unroll
        for (int q = 0; q < 4; ++q) {
            const f32x4 a = *(const f32x4*)(src + idx + 4 * q);
            int t = 0;
            t = __builtin_amdgcn_cvt_pk_fp8_f32(a[0] * scale, a[1] * scale, t, false);
            t = __builtin_amdgcn_cvt_pk_fp8_f32(a[2] * scale, a[3] * scale, t, true);
            w[q] = (unsigned)t;
        }
        *(u32x4*)(dst + idx) = w;
    }
}
DI void convert4_rows(const float* src, unsigned char* dst, float* rowscale, int job) {
    const int tid = threadIdx.x, lane = tid & 63, wave = tid >> 6;
    const int row = job * 4 + wave;
    const float* sp = src + (size_t)row * D;
    f32x4 v[2][4];
    float am = 0.f;
#pragma unroll
    for (int c = 0; c < 2; ++c)
#pragma unroll
        for (int q = 0; q < 4; ++q) {
            v[c][q] = *(const f32x4*)(sp + c * 1024 + lane * 16 + 4 * q);
            am = fmaxf(am, fmaxf(fmaxf(fabsf(v[c][q][0]), fabsf(v[c][q][1])), fmaxf(fabsf(v[c][q][2]), fabsf(v[c][q][3]))));
        }
#pragma unroll
    for (int o = 32; o > 0; o >>= 1) am = fmaxf(am, shxf(am, o));
    const float sc = am > 0.f ? am * (1.0f / 6.0f) : 1.0f, inv = 1.0f / sc;
    if (lane == 0) rowscale[row] = sc;
#pragma unroll
    for (int c = 0; c < 2; ++c) {
        u32x2 w;
#pragma unroll
        for (int d = 0; d < 2; ++d) {
            unsigned t = 0;
            const f32x4 a = v[c][2 * d], b = v[c][2 * d + 1];
            t = __builtin_amdgcn_cvt_scalef32_pk_fp4_f32(t, a[0] * inv, a[1] * inv, 1.0f, 0);
            t = __builtin_amdgcn_cvt_scalef32_pk_fp4_f32(t, a[2] * inv, a[3] * inv, 1.0f, 1);
            t = __builtin_amdgcn_cvt_scalef32_pk_fp4_f32(t, b[0] * inv, b[1] * inv, 1.0f, 2);
            t = __builtin_amdgcn_cvt_scalef32_pk_fp4_f32(t, b[2] * inv, b[3] * inv, 1.0f, 3);
            w[d] = t;
        }
        *(u32x2*)(dst + (size_t)row * 1024 + c * 512 + lane * 8) = w;
    }
}
DI void convert_i4_rows(const float* src, unsigned char* dst, float* rowscale, int job) {
    const int tid = threadIdx.x, lane = tid & 63, wave = tid >> 6;
    const int row = job * 4 + wave;
    const float* sp = src + (size_t)row * D;
    f32x4 v[2][4];
    float am = 0.f;
#pragma unroll
    for (int c = 0; c < 2; ++c)
#pragma unroll
        for (int q = 0; q < 4; ++q) {
            v[c][q] = *(const f32x4*)(sp + c * 1024 + lane * 16 + 4 * q);
            am = fmaxf(am, fmaxf(fmaxf(fabsf(v[c][q][0]), fabsf(v[c][q][1])), fmaxf(fabsf(v[c][q][2]), fabsf(v[c][q][3]))));
        }
#pragma unroll
    for (int o = 32; o > 0; o >>= 1) am = fmaxf(am, shxf(am, o));
    const float sc = am > 0.f ? am * (1.0f / 7.0f) : 1.0f, inv = 1.0f / sc;
    if (lane == 0) rowscale[row] = sc;
#pragma unroll
    for (int c = 0; c < 2; ++c) {
        u32x2 w;
#pragma unroll
        for (int d = 0; d < 2; ++d) {
            unsigned t = 0;
#pragma unroll
            for (int j = 0; j < 8; ++j) {
                const float x = v[c][2 * d + (j >> 2)][j & 3] * inv;
                const int qi = (int)fminf(fmaxf(rintf(x), -7.0f), 7.0f);
                t |= ((unsigned)qi & 0xFu) << (4 * j);
            }
            w[d] = t;
        }
        *(u32x2*)(dst + (size_t)row * 1024 + c * 512 + lane * 8) = w;
    }
}
DI void phase0(const Params& p, unsigned char* smem) {
    const int tid = threadIdx.x, lane = tid & 63, wave = tid >> 6;
    unsigned char* ws = p.ws;
    constexpr int J_NORM = 2432, J_TR = 8960, J_CV = 10528 - 8192, J_ROPE = 66, J_ALL = J_NORM + J_TR + J_CV + J_ROPE;
    for (int job = blockIdx.x; job < J_ALL; job += gridDim.x) {
        if (job >= J_NORM + J_TR + J_CV) {
            const int idx = (job - (J_NORM + J_TR + J_CV)) * 256 + tid;
            const int pos = idx >> 3, i = idx & 7;
            const float inv = exp2f(-(float)i * (18.931568569324174f / 8.0f));
            float sn, cs; sincosf((float)pos * inv, &sn, &cs);
            ((f32x2*)(ws + WS_ROPE))[idx] = (f32x2){cs, sn};
            continue;
        }
        if (job < J_NORM) {
            const int row = job * 4 + wave;
            if (row < MT) {
                const float* x = row < NP ? p.in[I_XP] + (size_t)row * D : p.in[I_XS] + (size_t)(row - NP) * D;
                rmsnorm_row_to_bf16(x, p.in[I_NMIXG], (bf16_t*)(ws + WS_HB) + (size_t)row * D, lane);
            } else {
                const int mr = row - MT;
                rmsnorm_row_to_bf16(p.in[I_MEMP] + (size_t)mr * D, p.in[I_NMEMG], (bf16_t*)(ws + WS_MEMHB) + (size_t)mr * D, lane);
            }
        } else if (job < J_NORM + J_TR) {
            int j = job - J_NORM;
            if (j < 5376) { transpose_tile(p.in[I_WIN], INW, (bf16_t*)(ws + WS_WINT), j / 168, j % 168, smem); }
            else if (j < 5376 + 512) { j -= 5376; transpose_tile(p.in[I_WMEMKV], 1024, (bf16_t*)(ws + WS_WMEMT), j / 16, j % 16, smem); }
            else if (j < 5888 + 1024) { j -= 5888; transpose_tile(p.in[I_WBR], 2048, (bf16_t*)(ws + WS_WBT), j / 32, j % 32, smem); }
            else if (j < 6912 + 1024) { j -= 6912; transpose_tile(p.in[I_WOUT], 2048, (bf16_t*)(ws + WS_WOT), j / 32, j % 32, smem); }
            else { j -= 7936; transpose_tile(p.in[I_PWQ], 2048, (bf16_t*)(ws + WS_WQT), j / 32, j % 32, smem); }
        } else {
            int j = job - J_NORM - J_TR + 8192;
            if (j < 8192) {   }
            else if (j < 9216) { j -= 8192; const int b = j >> 7, jj = j & 127; convert_job(p.in[I_CDK] + (size_t)b * 1048576, (bf16_t*)(ws + WS_KS) + (size_t)b * 1088 * 1024, jj); }
            else if (j < 10240) { j -= 9216; const int b = j >> 7, jj = j & 127; convert_job(p.in[I_CDV] + (size_t)b * 1048576, (bf16_t*)(ws + WS_VS) + (size_t)b * 1088 * 1024, jj); }
            else if (j < 10368) convert_job(p.in[I_CMK], (bf16_t*)(ws + WS_CMK), j - 10240);
            else if (j < 10496) convert_job(p.in[I_CMV], (bf16_t*)(ws + WS_CMV), j - 10368);
            else convert_job(p.in[I_PSK], (bf16_t*)(ws + WS_SKB), j - 10496);
        }
    }
}

DI void phase1(const Params& p, unsigned char* smem) {
    unsigned char* ws = p.ws;
    const bf16_t* Hb = (const bf16_t*)(ws + WS_HB);
    const bf16_t* WinT = (const bf16_t*)(ws + WS_WINT);
    bf16_t* P = (bf16_t*)(ws + WS_P);
    for_tiles(34, 84, [&](int tm, int tn) {
        f32x16 acc[4][2];
#pragma unroll
        for (int mi = 0; mi < 4; ++mi) acc[mi][0] = acc[mi][1] = zero16();
        gemm_kloop<4, 3>(acc, Hb + (size_t)tm * 256 * D, D, WinT + (size_t)tn * 128 * D, D, 64, smem);
        bf16_t* o = P + (size_t)tm * 256 * INW + tn * 128;
        EPI_STORE_BF16(4, acc, o, INW)
    });
    const bf16_t* MemHb = (const bf16_t*)(ws + WS_MEMHB);
    const bf16_t* WmemT = (const bf16_t*)(ws + WS_WMEMT);
    float* MemKV = (float*)(ws + WS_MEMKV);
    for (int t = gridDim.x - 1 - blockIdx.x; t < 32; t += gridDim.x) {
        const int tm = t >> 3, tn = t & 7;
        f32x16 acc[4][2];
#pragma unroll
        for (int mi = 0; mi < 4; ++mi) acc[mi][0] = acc[mi][1] = zero16();
        gemm_kloop<4, 3>(acc, MemHb + (size_t)tm * 256 * D, D, WmemT + (size_t)tn * 128 * D, D, 64, smem);
        float* o = MemKV + (size_t)tm * 256 * 1024 + tn * 128;
        EPI_FOR(4, acc, { o[row * 1024 + col] = v; })
    }
}

DI void qk_norm_rope(float* v, f32x4 g0, f32x4 g1, int gl, const float* cs, const float* sn, float scale) {
    float ss = 0.f;
#pragma unroll
    for (int i = 0; i < 8; ++i) ss += v[i] * v[i];
    ss += shxf(ss, 1); ss += shxf(ss, 2); ss += shxf(ss, 4);
    const float rstd = rsqrtf(ss * (1.0f / 64.0f) + EPS);
    float y[8];
#pragma unroll
    for (int i = 0; i < 4; ++i) { y[i] = v[i] * rstd * g0[i]; y[4 + i] = v[4 + i] * rstd * g1[i]; }
#pragma unroll
    for (int i = 0; i < 8; ++i) {
        const float pr = shxf(y[i], 1);
        float o = y[i];
        if (gl == 0) o = y[i] * cs[i] - pr * sn[i];
        else if (gl == 1) o = y[i] * cs[i] + pr * sn[i];
        v[i] = o * scale;
    }
}
DI void phase2(const Params& p, unsigned char* smem) {
    const int tid = threadIdx.x, lane = tid & 63, wave = tid >> 6;
    unsigned char* ws = p.ws;
    bf16_t* P = (bf16_t*)(ws + WS_P);
    float* out = p.out;
    constexpr int J_TOK = 2176, J_MEM = 256;
    for (int job = blockIdx.x; job < J_TOK + J_MEM; job += gridDim.x) {
        if (job < J_TOK) {
            const int row = job * 4 + wave;
            const bool samp = row >= NP;
            const int rs = row - NP;
            const int pos = samp ? 1024 + (rs & 63) : (row & 2047);
            bf16_t* pr = P + (size_t)row * INW;
            u32x4 in[9];
#pragma unroll
            for (int c = 0; c < 9; ++c) in[c] = *(const u32x4*)(pr + c * 512 + lane * 8);
            float cs[8], sn[8];
            {
                const f32x4* rt = (const f32x4*)(ws + WS_ROPE) + pos * 4;
#pragma unroll
                for (int i = 0; i < 4; ++i) { const f32x4 v = rt[i]; cs[2 * i] = v[0]; sn[2 * i] = v[1]; cs[2 * i + 1] = v[2]; sn[2 * i + 1] = v[3]; }
            }
            const int gl = lane & 7;
            const f32x4 qg0 = *(const f32x4*)(p.in[I_QNG] + gl * 8), qg1 = *(const f32x4*)(p.in[I_QNG] + gl * 8 + 4);
            const f32x4 kg0 = *(const f32x4*)(p.in[I_KNG] + gl * 8), kg1 = *(const f32x4*)(p.in[I_KNG] + gl * 8 + 4);
            const f32x4 lg0 = *(const f32x4*)(p.in[I_CMLNG] + lane * 8), lg1 = *(const f32x4*)(p.in[I_CMLNG] + lane * 8 + 4);
            const f32x4 lb0 = *(const f32x4*)(p.in[I_CMLNB] + lane * 8), lb1 = *(const f32x4*)(p.in[I_CMLNB] + lane * 8 + 4);
            const f32x4 mg0 = *(const f32x4*)(p.in[I_MQNG] + (lane & 15) * 8), mg1 = *(const f32x4*)(p.in[I_MQNG] + (lane & 15) * 8 + 4);
#pragma unroll
            for (int ps = 0; ps < 2; ++ps) {
                float f[8]; unpack8(in[ps], f);
                qk_norm_rope(f, qg0, qg1, gl, cs, sn, 0.125f * LOG2E);
                *(u32x4*)(pr + OFF_Q + ps * 512 + lane * 8) = pack8(f);
            }
#pragma unroll
            for (int ps = 0; ps < 2; ++ps) {
                const int c = ps * 512 + lane * 8;
                float f[8]; unpack8(in[2 + ps], f);
                qk_norm_rope(f, kg0, kg1, gl, cs, sn, 1.0f);
                float* ko = samp ? out + O_KS + (size_t)rs * 1024 + c : out + O_KP + (size_t)row * 1024 + c;
                *(f32x4*)ko = (f32x4){f[0], f[1], f[2], f[3]};
                *(f32x4*)(ko + 4) = (f32x4){f[4], f[5], f[6], f[7]};
                const u32x4 w = pack8(f);
                if (samp) *(u32x4*)((bf16_t*)(ws + WS_KS) + ((size_t)(rs >> 6) * 1088 + 1024 + (rs & 63)) * 1024 + c) = w;
                else *(u32x4*)(pr + OFF_K + c) = w;
            }
#pragma unroll
            for (int ps = 0; ps < 2; ++ps) {
                const int c = ps * 512 + lane * 8;
                const u32x4 w = in[4 + ps];
                float f[8]; unpack8(w, f);
                float* vo = samp ? out + O_VS + (size_t)rs * 1024 + c : out + O_VP + (size_t)row * 1024 + c;
                *(f32x4*)vo = (f32x4){f[0], f[1], f[2], f[3]};
                *(f32x4*)(vo + 4) = (f32x4){f[4], f[5], f[6], f[7]};
                if (samp) *(u32x4*)((bf16_t*)(ws + WS_VS) + ((size_t)(rs >> 6) * 1088 + 1024 + (rs & 63)) * 1024 + c) = w;
            }
            {
                float f[8]; unpack8(in[6], f);
#pragma unroll
                for (int i = 0; i < 8; ++i) f[i] = gelu_fast(f[i]);
                *(u32x4*)(pr + OFF_U + lane * 8) = pack8(f);
            }
            {
                const int c = lane * 8;
                float f[8]; unpack8(in[7], f);
                float sm = 0.f;
#pragma unroll
                for (int i = 0; i < 8; ++i) { f[i] = gelu_fast(f[i]); sm += f[i]; }
                const float mu = wave_sum(sm) * (1.0f / 512.0f);
                float q = 0.f;
#pragma unroll
                for (int i = 0; i < 8; ++i) { f[i] -= mu; q += f[i] * f[i]; }
                const float rstd = rsqrtf(wave_sum(q) * (1.0f / 512.0f) + EPS);
#pragma unroll
                for (int i = 0; i < 4; ++i) { f[i] = f[i] * rstd * lg0[i] + lb0[i]; f[4 + i] = f[4 + i] * rstd * lg1[i] + lb1[i]; }
                *(u32x4*)(pr + OFF_VC + c) = pack8(f);
                if (samp) {
                    float* co = out + O_CVS + (size_t)rs * 512 + c;
                    *(f32x4*)co = (f32x4){f[0], f[1], f[2], f[3]};
                    *(f32x4*)(co + 4) = (f32x4){f[4], f[5], f[6], f[7]};
                }
            }
            {
                float f[8]; unpack8(in[8], f);
                float ss = 0.f;
#pragma unroll
                for (int i = 0; i < 8; ++i) ss += f[i] * f[i];
                ss += shxf(ss, 1); ss += shxf(ss, 2); ss += shxf(ss, 4); ss += shxf(ss, 8);
                const float rstd = rsqrtf(ss * (1.0f / 128.0f) + EPS) * (0.08838834764831845f * LOG2E);
#pragma unroll
                for (int i = 0; i < 4; ++i) { f[i] = f[i] * rstd * mg0[i]; f[4 + i] = f[4 + i] * rstd * mg1[i]; }
                *(u32x4*)(pr + OFF_QM + lane * 8) = pack8(f);
            }
        } else {
            const int row = (job - J_TOK) * 4 + wave;
            const float* src = (const float*)(ws + WS_MEMKV) + (size_t)row * 1024;
            {
                const int c = lane * 8;
                const f32x4 a = *(const f32x4*)(src + c), b = *(const f32x4*)(src + c + 4);
                float f[8] = {a[0], a[1], a[2], a[3], b[0], b[1], b[2], b[3]};
                float ss = 0.f;
#pragma unroll
                for (int i = 0; i < 8; ++i) ss += f[i] * f[i];
                ss += shxf(ss, 1); ss += shxf(ss, 2); ss += shxf(ss, 4); ss += shxf(ss, 8);
                const float rstd = rsqrtf(ss * (1.0f / 128.0f) + EPS);
                const float* g = p.in[I_MKNG] + (lane & 15) * 8;
#pragma unroll
                for (int i = 0; i < 8; ++i) f[i] = f[i] * rstd * g[i];
                float* ko = out + O_MKP + (size_t)row * 512 + c;
                *(f32x4*)ko = (f32x4){f[0], f[1], f[2], f[3]};
                *(f32x4*)(ko + 4) = (f32x4){f[4], f[5], f[6], f[7]};
                *(u32x4*)((bf16_t*)(ws + WS_MEMKB) + (size_t)row * 512 + c) = pack8(f);
            }
            {
                const int c = lane * 8;
                const f32x4 a = *(const f32x4*)(src + 512 + c), b = *(const f32x4*)(src + 512 + c + 4);
                float f[8] = {a[0], a[1], a[2], a[3], b[0], b[1], b[2], b[3]};
                float* vo = out + O_MVP + (size_t)row * 512 + c;
                *(f32x4*)vo = a; *(f32x4*)(vo + 4) = b;
                *(u32x4*)((bf16_t*)(ws + WS_MEMVB) + (size_t)row * 512 + c) = pack8(f);
            }
        }
    }
}

template <int DQK, int KW, bool PF>
DI void attn_main(const bf16_t* Qw, int qstride, const bf16_t* Kg, size_t kstride, const bf16_t* Vg, size_t vstride, int nkt, int kcol, int vcol,
                  unsigned char* smem, f32x16 (&o)[4], float& m_run, float& l_run) {
    constexpr int KROW = KW * 2 + 16, VROW = KW * 2 + 32, VOFF = 64 * KROW, CPR = KW / 8, NCH = KW / 32, NKS = DQK / 16;
    const int tid = opaque_tid(), lane = tid & 63, r = lane & 31, h = lane >> 5;
    bf16x8 qf[NKS];
#pragma unroll
    for (int ks = 0; ks < NKS; ++ks) qf[ks] = *(const bf16x8*)(Qw + (size_t)r * qstride + ks * 16 + h * 8);
#pragma unroll
    for (int dt = 0; dt < 4; ++dt) o[dt] = zero16();
    m_run = -INFINITY; l_run = 0.f;
    u32x4 rk[NCH], rv[PF ? NCH : 1];
    constexpr int RPI = 256 / CPR;
    const unsigned kvo = (unsigned)((tid / CPR) * (int)kstride * 2 + (tid % CPR) * 16);
    const unsigned vvo = (unsigned)((tid / CPR) * (int)vstride * 2 + (tid % CPR) * 16);
    const int wlo = (tid / CPR) * KROW + (tid % CPR) * 16, wlv = VOFF + (tid / CPR) * VROW + (tid % CPR) * 16;
    if (PF) {
#pragma unroll
        for (int i = 0; i < NCH; ++i) { rk[i] = *(const u32x4*)((const char*)(Kg + (size_t)(i * RPI) * kstride) + kvo); rv[i] = *(const u32x4*)((const char*)(Vg + (size_t)(i * RPI) * vstride) + vvo); }
    }
    const int gi = lane >> 4, i16 = lane & 15, tq = i16 >> 2, tp = i16 & 3;
    const unsigned char* vbase = smem + VOFF + (4 * h + tq) * VROW + (vcol + 16 * (gi & 1)) * 2 + 8 * tp;
    const unsigned char* kbase = smem + r * KROW + (kcol + h * 8) * 2;
#pragma unroll 1
    for (int kt = 0; kt < nkt; ++kt) {
        if (!PF) {
#pragma unroll
            for (int i = 0; i < NCH; ++i) rk[i] = *(const u32x4*)((const char*)(Kg + (size_t)(kt * 64 + i * RPI) * kstride) + kvo);
        }
        __syncthreads();
        if (PF) {
#pragma unroll
            for (int i = 0; i < NCH; ++i) { *(u32x4*)(smem + wlo + i * RPI * KROW) = rk[i]; *(u32x4*)(smem + wlv + i * RPI * VROW) = rv[i]; }
        } else {
#pragma unroll
            for (int i = 0; i < NCH; ++i) *(u32x4*)(smem + wlo + i * RPI * KROW) = rk[i];
#pragma unroll
            for (int i = 0; i < NCH; ++i) rk[i] = *(const u32x4*)((const char*)(Vg + (size_t)(kt * 64 + i * RPI) * vstride) + vvo);
#pragma unroll
            for (int i = 0; i < NCH; ++i) *(u32x4*)(smem + wlv + i * RPI * VROW) = rk[i];
        }
        __syncthreads();
        if (PF && kt + 1 < nkt) {
#pragma unroll
            for (int i = 0; i < NCH; ++i) { rk[i] = *(const u32x4*)((const char*)(Kg + (size_t)((kt + 1) * 64 + i * RPI) * kstride) + kvo); rv[i] = *(const u32x4*)((const char*)(Vg + (size_t)((kt + 1) * 64 + i * RPI) * vstride) + vvo); }
        }
        f32x16 x[2];
#pragma unroll
        for (int mt = 0; mt < 2; ++mt) {
            bf16x8 kf[NKS];
#pragma unroll
            for (int ks = 0; ks < NKS; ++ks) kf[ks] = *(const bf16x8*)(kbase + mt * 32 * KROW + ks * 32);
            x[mt] = zero16();
#pragma unroll
            for (int ks = 0; ks < NKS; ++ks) x[mt] = MFMA32(kf[ks], qf[ks], x[mt]);
        }
        bf16x8 av[2][4];
#pragma unroll
        for (int f = 0; f < 4; ++f) { const int kb = 32 * (f >> 1) + 16 * (f & 1); av[0][f] = tr_pair(vbase + kb * VROW, vbase + (kb + 8) * VROW); }
        float mx = x[0][0];
#pragma unroll
        for (int mt = 0; mt < 2; ++mt)
#pragma unroll
            for (int i = 0; i < 16; ++i) mx = fmaxf(mx, x[mt][i]);
        mx = fmaxf(mx, shxf(mx, 32));
        const float mnew = fmaxf(m_run, mx);
        const float alpha = __builtin_amdgcn_exp2f(m_run - mnew);
        m_run = mnew;
        float psum = 0.f;
#pragma unroll
        for (int mt = 0; mt < 2; ++mt)
#pragma unroll
            for (int i = 0; i < 16; ++i) { x[mt][i] = __builtin_amdgcn_exp2f(x[mt][i] - mnew); psum += x[mt][i]; }
        l_run = l_run * alpha + psum;
#pragma unroll
        for (int dt = 0; dt < 4; ++dt) o[dt] = o[dt] * alpha;
        bf16x8 pb[2][2];
#pragma unroll
        for (int mt = 0; mt < 2; ++mt)
#pragma unroll
            for (int s = 0; s < 2; ++s) {
                u32x4 w;
                w.x = pk2(x[mt][8 * s + 0], x[mt][8 * s + 1]); w.y = pk2(x[mt][8 * s + 2], x[mt][8 * s + 3]);
                w.z = pk2(x[mt][8 * s + 4], x[mt][8 * s + 5]); w.w = pk2(x[mt][8 * s + 6], x[mt][8 * s + 7]);
                pb[mt][s] = __builtin_bit_cast(bf16x8, w);
            }
#pragma unroll
        for (int dt = 0; dt < 4; ++dt) {
            if (dt < 3) {
#pragma unroll
                for (int f = 0; f < 4; ++f) { const int kb = 32 * (f >> 1) + 16 * (f & 1); av[(dt + 1) & 1][f] = tr_pair(vbase + kb * VROW + (dt + 1) * 64, vbase + (kb + 8) * VROW + (dt + 1) * 64); }
            }
#pragma unroll
            for (int f = 0; f < 4; ++f) o[dt] = MFMA32(av[dt & 1][f], pb[f >> 1][f & 1], o[dt]);
        }
    }
}

DI void diff_item(const Params& p, unsigned char* smem, float lam, bool samp, int b, int hh, int c) {
    unsigned char* ws = p.ws;
    const bf16_t* P = (const bf16_t*)(ws + WS_P);
    const int tid = opaque_tid(), lane = tid & 63, wave = tid >> 6, r = lane & 31, h = lane >> 5;
    const int comp = wave >> 1, half = wave & 1;
    const int row0 = samp ? NP + b * 64 : b * 2048 + c * 64;
    const bf16_t* Qw = P + (size_t)(row0 + 32 * half) * INW + OFF_Q + hh * 128 + comp * 64;
    const bf16_t *Kg, *Vg; size_t kst; int nkt;
    if (samp) { Kg = (const bf16_t*)(ws + WS_KS) + (size_t)b * 1088 * 1024 + hh * 128; Vg = (const bf16_t*)(ws + WS_VS) + (size_t)b * 1088 * 1024 + hh * 128; kst = 1024; nkt = 17; }
    else { Kg = P + (size_t)b * 2048 * INW + OFF_K + hh * 128; Vg = P + (size_t)b * 2048 * INW + OFF_V + hh * 128; kst = INW; nkt = c + 1; }
    f32x16 o[4]; float m_run, l_run;
    attn_main<64, 128, true>(Qw, INW, Kg, kst, Vg, kst, nkt, comp * 64, 0, smem, o, m_run, l_run);
    const float inv = 1.0f / (l_run + shxf(l_run, 32));
    float* xch = (float*)smem;
    __syncthreads();
    if (comp == 1) {
#pragma unroll
        for (int dt = 0; dt < 4; ++dt)
#pragma unroll
            for (int ig = 0; ig < 4; ++ig) {
                f32x4 w = {o[dt][4 * ig] * inv, o[dt][4 * ig + 1] * inv, o[dt][4 * ig + 2] * inv, o[dt][4 * ig + 3] * inv};
                *(f32x4*)(xch + (32 * half + r) * 132 + 32 * dt + 8 * ig + 4 * h) = w;
            }
    }
    __syncthreads();
    if (comp == 0) {
        float ss = 0.f;
#pragma unroll
        for (int dt = 0; dt < 4; ++dt)
#pragma unroll
            for (int ig = 0; ig < 4; ++ig) {
                const f32x4 w = *(const f32x4*)(xch + (32 * half + r) * 132 + 32 * dt + 8 * ig + 4 * h);
#pragma unroll
                for (int j = 0; j < 4; ++j) { const float v = o[dt][4 * ig + j] * inv - lam * w[j]; o[dt][4 * ig + j] = v; ss += v * v; }
            }
        ss += shxf(ss, 32);
        const float rstd = rsqrtf(ss * (1.0f / 128.0f) + EPS) * 0.8f;
        bf16_t* mo = (bf16_t*)(ws + WS_MIXIN) + (size_t)(row0 + 32 * half + r) * D + hh * 128;
        const float* og = p.in[I_OUTG];
        f32x4 gq[4][4];
#pragma unroll
        for (int dt = 0; dt < 4; ++dt)
#pragma unroll
            for (int ig = 0; ig < 4; ++ig) gq[dt][ig] = *(const f32x4*)(og + 32 * dt + 8 * ig + 4 * h);
#pragma unroll
        for (int dt = 0; dt < 4; ++dt)
#pragma unroll
            for (int ig = 0; ig < 4; ++ig) {
                const int d0 = 32 * dt + 8 * ig + 4 * h;
                const f32x4 g = gq[dt][ig];
                u32x2 w; w.x = pk2(o[dt][4 * ig] * rstd * g[0], o[dt][4 * ig + 1] * rstd * g[1]); w.y = pk2(o[dt][4 * ig + 2] * rstd * g[2], o[dt][4 * ig + 3] * rstd * g[3]);
                *(u32x2*)(mo + d0) = w;
            }
    }
}

DI void mem_item(const Params& p, unsigned char* smem, int rt, int hp) {
    unsigned char* ws = p.ws;
    const bf16_t* P = (const bf16_t*)(ws + WS_P);
    const int tid = opaque_tid(), lane = tid & 63, wave = tid >> 6, r = lane & 31, h = lane >> 5;
    const int head = 2 * hp + (wave >> 1), half = wave & 1;
    const int row0 = rt * 64;
    const bf16_t *Kg, *Vg;
    if (rt < 128) { const int b = rt >> 5; Kg = (const bf16_t*)(ws + WS_MEMKB) + (size_t)b * 256 * 512 + hp * 256; Vg = (const bf16_t*)(ws + WS_MEMVB) + (size_t)b * 256 * 512 + hp * 256; }
    else { const int b = rt - 128; Kg = (const bf16_t*)(ws + WS_CMK) + (size_t)b * 256 * 512 + hp * 256; Vg = (const bf16_t*)(ws + WS_CMV) + (size_t)b * 256 * 512 + hp * 256; }
    const bf16_t* Qw = P + (size_t)(row0 + 32 * half) * INW + OFF_QM + head * 128;
    f32x16 o[4]; float m_run, l_run;
    attn_main<128, 256, false>(Qw, INW, Kg, 512, Vg, 512, 4, (wave >> 1) * 128, (wave >> 1) * 128, smem, o, m_run, l_run);
    const float inv = 1.0f / (l_run + shxf(l_run, 32));
    bf16_t* mo = (bf16_t*)(ws + WS_MIXIN) + (size_t)(row0 + 32 * half + r) * D + 1536 + head * 128;
#pragma unroll
    for (int dt = 0; dt < 4; ++dt)
#pragma unroll
        for (int ig = 0; ig < 4; ++ig) {
            const int d0 = 32 * dt + 8 * ig + 4 * h;
            u32x2 w; w.x = pk2(o[dt][4 * ig] * inv, o[dt][4 * ig + 1] * inv); w.y = pk2(o[dt][4 * ig + 2] * inv, o[dt][4 * ig + 3] * inv);
            *(u32x2*)(mo + d0) = w;
        }
}

DI void mlp_item(const Params& p, unsigned char* smem, int idx) {
    unsigned char* ws = p.ws;
    const bf16_t* P = (const bf16_t*)(ws + WS_P);
    const int tid = opaque_tid(), lane = tid & 63, wave = tid >> 6, r = lane & 31, h = lane >> 5;
    int row0, L, g;
    if (idx < 256) { const int b = idx >> 6, ch = (idx >> 2) & 15; g = idx & 3; row0 = b * 2048 + ch * 128; L = 128; }
    else { const int j = idx - 256; g = j & 3; row0 = NP + (j >> 2) * 64; L = 64; }
    constexpr int VROW = 288;
    __syncthreads();
    for (int c = tid; c < L * 16; c += 256) {
        const int s = c >> 4, cc = c & 15;
        *(u32x4*)(smem + s * VROW + cc * 16) = *(const u32x4*)(P + (size_t)(row0 + s) * INW + OFF_VC + g * 128 + cc * 8);
    }
    __syncthreads();
    if (32 * wave < L) {
        const int t = 32 * wave + r;
        const float* wsrow = p.in[I_CMWS] + ((size_t)g * 128 + t) * 128;
        f32x16 acc[4];
#pragma unroll
        for (int mt = 0; mt < 4; ++mt) acc[mt] = zero16();
        const int gi = lane >> 4, i16 = lane & 15, tq = i16 >> 2, tp = i16 & 3;
        const unsigned char* vbase = smem + (4 * h + tq) * VROW + (16 * (gi & 1)) * 2 + 8 * tp;
        const int nks = 2 * wave + 2;
        f32x4 wa[8], wb[8];
#pragma unroll
        for (int ks = 0; ks < 8; ++ks)
            if (ks < nks) { const int s0 = 16 * ks + 4 * h; wa[ks] = *(const f32x4*)(wsrow + s0); wb[ks] = *(const f32x4*)(wsrow + s0 + 8); }
#pragma unroll
        for (int ks = 0; ks < 8; ++ks)
            if (ks < nks) {
                const int s0 = 16 * ks + 4 * h;
                f32x4 w0 = wa[ks], w1 = wb[ks];
#pragma unroll
                for (int j = 0; j < 4; ++j) { if (s0 + j > t) w0[j] = 0.f; if (s0 + 8 + j > t) w1[j] = 0.f; }
                u32x4 bw; bw.x = pk2(w0[0], w0[1]); bw.y = pk2(w0[2], w0[3]); bw.z = pk2(w1[0], w1[1]); bw.w = pk2(w1[2], w1[3]);
                const bf16x8 bfrag = __builtin_bit_cast(bf16x8, bw);
#pragma unroll
                for (int mt = 0; mt < 4; ++mt) {
                    const bf16x8 a = tr_pair(vbase + (16 * ks) * VROW + mt * 64, vbase + (16 * ks + 8) * VROW + mt * 64);
                    acc[mt] = MFMA32(a, bfrag, acc[mt]);
                }
            }
        const float bias = p.in[I_CMBS][g * 128 + t];
        const bf16_t* up = P + (size_t)(row0 + t) * INW + OFF_U + g * 128;
        bf16_t* mo = (bf16_t*)(ws + WS_MIXIN) + (size_t)(row0 + t) * D + 1024 + g * 128;
        u32x2 uv[4][4];
#pragma unroll
        for (int mt = 0; mt < 4; ++mt)
#pragma unroll
            for (int ig = 0; ig < 4; ++ig) uv[mt][ig] = *(const u32x2*)(up + 32 * mt + 8 * ig + 4 * h);
#pragma unroll
        for (int mt = 0; mt < 4; ++mt)
#pragma unroll
            for (int ig = 0; ig < 4; ++ig) {
                const int c0 = 32 * mt + 8 * ig + 4 * h;
                const u32x2 u = uv[mt][ig];
                u32x2 w;
                w.x = pk2(bflo(u.x) * (acc[mt][4 * ig] + bias), bfhi(u.x) * (acc[mt][4 * ig + 1] + bias));
                w.y = pk2(bflo(u.y) * (acc[mt][4 * ig + 2] + bias), bfhi(u.y) * (acc[mt][4 * ig + 3] + bias));
                *(u32x2*)(mo + c0) = w;
            }
    }
}

DI void phase3(const Params& p, unsigned char* smem) {
    __shared__ int4 s_p3;
    int& s_item = s_p3.x;
    float& s_lam = *(float*)&s_p3.y;
    const int tid = threadIdx.x;
    if (tid < 64) {
        float a = p.in[I_LQ1][tid] * p.in[I_LK1][tid], b = p.in[I_LQ2][tid] * p.in[I_LK2][tid];
        a = wave_sum(a); b = wave_sum(b);
        if (tid == 0) s_lam = expf(a) - expf(b) + 0.2f;
    }
    __syncthreads();
    const float lam = s_lam;
    unsigned* ctr = (unsigned*)(p.ws + WS_CTL);
    constexpr int N_ATT = 1648, N_CONV = 1024, N_ITEMS = N_ATT + N_CONV;
    for (;;) {
        __syncthreads();
        if (tid == 0) s_item = (int)atomicAdd(ctr, 1u);
        __syncthreads();
        const int id = __builtin_amdgcn_readfirstlane(s_item);
        if (id >= N_ITEMS) break;
        int it;
        if (id < 2 * N_CONV) {
            if ((id & 1) == 0) {
                const int cj = (id >> 1) * 8;
#pragma unroll 1
                for (int q = 0; q < 8; ++q) {
                    const int j = cj + q;
                    if (j < 4096) convert_i4_rows(p.in[I_PU], p.ws + WS_UB, (float*)(p.ws + WS_USC), j);
                    else convert4_rows(p.in[I_PV], p.ws + WS_VB, (float*)(p.ws + WS_VSC), j - 4096);
                }
                continue;
            }
            it = id >> 1;
        } else it = id - N_CONV;
        if (it < 480) { diff_item(p, smem, lam, false, (it & 31) >> 3, it & 7, 31 - (it >> 5)); }
        else if (it < 544) { const int j = it - 480; diff_item(p, smem, lam, true, j >> 3, j & 7, 0); }
        else if (it < 832) { const int j = it - 544; diff_item(p, smem, lam, false, (j & 31) >> 3, j & 7, 16 - (j >> 5)); }
        else if (it < 1104) { const int j = it - 832; mem_item(p, smem, j >> 1, j & 1); }
        else if (it < 1392) { mlp_item(p, smem, it - 1104); }
        else { const int j = it - 1392; diff_item(p, smem, lam, false, (j & 31) >> 3, j & 7, 7 - (j >> 5)); }
    }
}

template <int MI> struct RingDepth { static constexpr int v = MI == 4 ? 3 : 4; };
template <int MI> DI void p4_tile(const Params& p, unsigned char* smem, int row0, int tn) {
    unsigned char* ws = p.ws;
    const bf16_t* mixin = (const bf16_t*)(ws + WS_MIXIN);
    const bf16_t* WbT = (const bf16_t*)(ws + WS_WBT);
    const bf16_t* P = (const bf16_t*)(ws + WS_P);
    bf16_t* merged = (bf16_t*)(ws + WS_MERGED);
    f32x16 tot[MI][2];
#pragma unroll
    for (int mi = 0; mi < MI; ++mi) tot[mi][0] = tot[mi][1] = zero16();
    const float* bgp = p.in[I_BGATE] + tn * 128;
    constexpr int GROW = 272;
#pragma unroll 1
    for (int seg = 0; seg < 3; ++seg) {
        const int k0 = seg == 0 ? 0 : (seg == 1 ? 1024 : 1536), nk = seg == 0 ? 32 : 16;
        f32x16 acc[MI][2];
#pragma unroll
        for (int mi = 0; mi < MI; ++mi) acc[mi][0] = acc[mi][1] = zero16();
        gemm_kloop<MI, RingDepth<MI>::v>(acc, mixin + (size_t)row0 * D + k0, D, WbT + (size_t)tn * 128 * D + k0, D, nk, smem);
        {
            const int tid = opaque_tid();
            const bf16_t* gsrc = P + (size_t)row0 * INW + OFF_G + seg * 2048 + tn * 128;
            u32x4 gv[MI * 4];
#pragma unroll
            for (int i = 0; i < MI * 4; ++i) { const int c = tid + 256 * i; gv[i] = *(const u32x4*)(gsrc + (c >> 4) * INW + (c & 15) * 8); }
#pragma unroll
            for (int i = 0; i < MI * 4; ++i) { const int c = tid + 256 * i; *(u32x4*)(smem + (c >> 4) * GROW + (c & 15) * 16) = gv[i]; }
        }
        __syncthreads();
        const float* bseg = bgp + seg * 2048;
        EPI_FOR(MI, acc, {
            const float gl = bf2f(*(const bf16_t*)(smem + row * GROW + col * 2)) + bseg[col];
            const float gate = __builtin_amdgcn_rcpf(1.0f + __builtin_amdgcn_exp2f(gl * -LOG2E));
            tot[mi_][ni_][i_] += gate * v;
        })
        __syncthreads();
    }
    bf16_t* o = merged + (size_t)row0 * D + tn * 128;
    EPI_FOR(MI, tot, { o[row * D + col] = f2bf(v); })
}
DI void phase4(const Params& p, unsigned char* smem) {
    for_tiles(64, 16, [&](int tm, int tn) { p4_tile<2>(p, smem, tm * 128, tn); });
    for_tiles(8, 16, [&](int tm, int tn) { p4_tile<1>(p, smem, NP + tm * 64, tn); });
}

template <int MI> DI void p5_tile(const Params& p, unsigned char* smem, int row0, int tn) {
    unsigned char* ws = p.ws;
    const bf16_t* merged = (const bf16_t*)(ws + WS_MERGED);
    const bf16_t* WoT = (const bf16_t*)(ws + WS_WOT);
    bf16_t* x1g = (bf16_t*)(ws + WS_X1G);
    f32x16 acc[MI][2];
#pragma unroll
    for (int mi = 0; mi < MI; ++mi) acc[mi][0] = acc[mi][1] = zero16();
    gemm_kloop<MI, RingDepth<MI>::v>(acc, merged + (size_t)row0 * D, D, WoT + (size_t)tn * 128 * D, D, 64, smem);
    const float* xin = (row0 < NP ? p.in[I_XP] + (size_t)row0 * D : p.in[I_XS] + (size_t)(row0 - NP) * D) + tn * 128;
    float* y = p.out + O_Y + (size_t)row0 * D + tn * 128;
    bf16_t* xg = x1g + (size_t)row0 * D + tn * 128;
    const float* gfp = p.in[I_NFFNG] + tn * 128;
    {
        const int tid_ = opaque_tid(), lane_ = tid_ & 63, wave_ = tid_ >> 6, r_ = lane_ & 31, h_ = lane_ >> 5;
#pragma unroll
        for (int mi = 0; mi < MI; ++mi)
#pragma unroll
            for (int ni = 0; ni < 2; ++ni) {
                const int col = (wave_ & 1) * 64 + ni * 32 + r_;
                const float gcol = gfp[col];
                float xv[16];
#pragma unroll
                for (int i = 0; i < 16; ++i) xv[i] = xin[((wave_ >> 1) * 32 * MI + mi * 32 + crow(i, h_)) * D + col];
#pragma unroll
                for (int i = 0; i < 16; ++i) {
                    const int row = (wave_ >> 1) * 32 * MI + mi * 32 + crow(i, h_);
                    const float x1 = xv[i] + acc[mi][ni][i];
                    y[row * D + col] = x1;
                    xg[row * D + col] = f2bf(x1 * gcol);
                }
                asm volatile("" ::: "memory");
            }
    }
}
DI void phase5(const Params& p, unsigned char* smem) {
    for_tiles(32, 16, [&](int tm, int tn) { p5_tile<4>(p, smem, tm * 256, tn); });
    for_tiles(8, 16, [&](int tm, int tn) { p5_tile<1>(p, smem, NP + tm * 64, tn); });
}

DI void phase6(const Params& p, unsigned char* smem) {
    unsigned char* ws = p.ws;
    const bf16_t* x1g = (const bf16_t*)(ws + WS_X1G);
    const bf16_t* WqT = (const bf16_t*)(ws + WS_WQT);
    const bf16_t* SK = (const bf16_t*)(ws + WS_SKB);
    float* sc = (float*)(ws + WS_SCORES);
    constexpr int STAGE = 16384, A_BYTES = 8192;
    for_tiles(68, 16, [&](int tm, int tn) {
        f32x16 acc[2][2];
        acc[0][0] = acc[0][1] = acc[1][0] = acc[1][1] = zero16();
        gemm_kloop<2, 4>(acc, x1g + (size_t)tm * 128 * D, D, WqT + (size_t)tn * 128 * D, D, 64, smem);
        const int tid = opaque_tid(), lane = tid & 63, wave = tid >> 6, wm = wave >> 1, wn = wave & 1, r = lane & 31, h = lane >> 5;
        {
            const int frow = lane >> 2, fslot = lane & 3;
            const bf16_t* Bg = SK + (size_t)tn * 128 * 128;
#pragma unroll
            for (int sl = 0; sl < 4; ++sl)
#pragma unroll
                for (int i = 0; i < 2; ++i) {
                    const int R = (wave * 2 + i) * 16 + frow;
                    __builtin_amdgcn_global_load_lds((GLB1 const void*)(Bg + R * 128 + (fslot ^ ((R >> 2) & 3)) * 8 + sl * 32), (LDS3 void*)(smem + sl * STAGE + A_BYTES + (wave * 2 + i) * 1024), 16, 0, 0);
                }
        }
#pragma unroll
        for (int mi = 0; mi < 2; ++mi)
#pragma unroll
            for (int ni = 0; ni < 2; ++ni)
#pragma unroll
                for (int i = 0; i < 16; ++i) {
                    const int row = wm * 64 + mi * 32 + crow(i, h), k = wn * 64 + ni * 32 + r;
                    *(bf16_t*)(smem + (k >> 5) * STAGE + row * 64 + ((((k & 31) >> 3) ^ ((row >> 2) & 3)) * 16) + (k & 7) * 2) = f2bf(acc[mi][ni][i]);
                }
        asm volatile("s_waitcnt vmcnt(0)" ::: "memory");
        __syncthreads();
        f32x16 acc2[2][2];
        acc2[0][0] = acc2[0][1] = acc2[1][0] = acc2[1][1] = zero16();
        {
            const int sw = (r >> 2) & 3;
            const int a_rd = (wm * 64 + r) * 64, b_rd = A_BYTES + (wn * 64 + r) * 64;
#pragma unroll
            for (int sl = 0; sl < 4; ++sl)
#pragma unroll
                for (int ks = 0; ks < 2; ++ks) {
                    const unsigned char* st = smem + sl * STAGE;
                    const int ko = ((2 * ks + h) ^ sw) * 16;
                    const bf16x8 a0 = *(const bf16x8*)(st + a_rd + ko), a1 = *(const bf16x8*)(st + a_rd + 32 * 64 + ko);
                    const bf16x8 b0 = *(const bf16x8*)(st + b_rd + ko), b1 = *(const bf16x8*)(st + b_rd + 32 * 64 + ko);
                    acc2[0][0] = MFMA32(a0, b0, acc2[0][0]); acc2[0][1] = MFMA32(a0, b1, acc2[0][1]);
                    acc2[1][0] = MFMA32(a1, b0, acc2[1][0]); acc2[1][1] = MFMA32(a1, b1, acc2[1][1]);
                }
        }
        __syncthreads();
        float* o = sc + (size_t)tm * 128 * D + tn * 128;
        EPI_FOR(2, acc2, { o[row * D + col] = v; })
    });
}
DI void phase7(const Params& p, unsigned char* smem) {}

DI float dot2u(unsigned a, unsigned b, float acc) { return __builtin_amdgcn_fdot2_f32_bf16(__builtin_bit_cast(bf16v2, a), __builtin_bit_cast(bf16v2, b), acc, false); }
DI float dot8(u32x4 a, u32x4 b, float acc) {
    const unsigned a0 = a.x, a1 = a.y, a2 = a.z, a3 = a.w, b0 = b.x, b1 = b.y, b2 = b.z, b3 = b.w;
    acc = dot2u(a0, b0, acc); acc = dot2u(a1, b1, acc); acc = dot2u(a2, b2, acc); acc = dot2u(a3, b3, acc);
    return acc;
}
DI float rdl(float v, int i) { return __int_as_float(__builtin_amdgcn_readlane(__float_as_int(v), i)); }
DI int f2key(float f) { const int k = __float_as_int(f); return k ^ ((k >> 31) & 0x7fffffff); }
DI int imax(int a, int b) { return a > b ? a : b; }
DI int imin(int a, int b) { return a < b ? a : b; }
DI void bitonic128(int& a, int& b, int lane) {
#pragma unroll
    for (int k = 2; k <= 128; k <<= 1) {
#pragma unroll
        for (int j = k >> 1; j > 0; j >>= 1) {
            if (j == 64) { const int na = imax(a, b), nb = imin(a, b); a = na; b = nb; }
            else {
                const int pa = shx(a, j), pb = shx(b, j);
                const bool lowj = (lane & j) == 0;
                bool kma, kmb;
                if (k < 64) { kma = ((lane & k) == 0) == lowj; kmb = kma; }
                else if (k == 64) { kma = lowj; kmb = !lowj; }
                else { kma = lowj; kmb = lowj; }
                a = kma ? imax(a, pa) : imin(a, pa);
                b = kmb ? imax(b, pb) : imin(b, pb);
            }
        }
    }
}
DI void bitonic64(int& a, int lane) {
#pragma unroll
    for (int k = 2; k <= 64; k <<= 1) {
#pragma unroll
        for (int j = k >> 1; j > 0; j >>= 1) {
            const int pa = shx(a, j);
            const bool lowj = (lane & j) == 0;
            const bool km = (k < 64) ? (((lane & k) == 0) == lowj) : lowj;
            a = km ? imax(a, pa) : imin(a, pa);
        }
    }
}
DI void phase8(const Params& p, unsigned char* smem) {
    unsigned char* ws = p.ws;
    const int tid = threadIdx.x, lane = tid & 63, wave = tid >> 6;
    const bf16_t* x1g = (const bf16_t*)(ws + WS_X1G);
    const float* scores = (const float*)(ws + WS_SCORES);
    const unsigned char* Ub = ws + WS_UB;
    const float* usc = (const float*)(ws + WS_USC);
    const unsigned char* Vb = ws + WS_VB;
    const float* vsc = (const float*)(ws + WS_VSC);
    int ca = 0, cb = lane, cvalid = 0;
#pragma unroll
    for (int aa = 0; aa < 16; ++aa) { const int cnt = 16 / (aa + 1); if (!cvalid) { if (cb < cnt) { ca = aa; cvalid = 1; } else cb -= cnt; } }
    if (!cvalid) { ca = 0; cb = 0; }

    int* wge = (int*)(smem + wave * 1024);
    float* wgg = (float*)(smem + wave * 1024 + 512);
    for (int t = blockIdx.x * 4 + wave; t < MT; t += gridDim.x * 4) {
        float* yrow = p.out + O_Y + (size_t)t * D;
        float ss = 0.f;
#pragma unroll
        for (int c = 0; c < 2; ++c)
#pragma unroll
            for (int q = 0; q < 4; ++q) { const f32x4 xv = *(const f32x4*)(yrow + c * 1024 + lane * 16 + 4 * q); ss += xv[0] * xv[0] + xv[1] * xv[1] + xv[2] * xv[2] + xv[3] * xv[3]; }
        const float rstd = rsqrtf(wave_sum(ss) * (1.0f / 2048.0f) + EPS);
        unsigned hq1[2][2], hq2[2][2];
        float hs1, hs2;
        {
            float hf[2][16];
            float am = 0.f;
#pragma unroll
            for (int c = 0; c < 2; ++c) {
                const u32x4 h0 = *(const u32x4*)(x1g + (size_t)t * D + c * 1024 + lane * 16), h1 = *(const u32x4*)(x1g + (size_t)t * D + c * 1024 + lane * 16 + 8);
                unpack8(h0, &hf[c][0]); unpack8(h1, &hf[c][8]);
#pragma unroll
                for (int j = 0; j < 16; ++j) am = fmaxf(am, fabsf(hf[c][j]));
            }
#pragma unroll
            for (int o = 32; o > 0; o >>= 1) am = fmaxf(am, shxf(am, o));
            hs1 = am > 0.f ? am * (1.0f / 7.0f) : 1.0f; hs2 = hs1 * (1.0f / 14.0f);
            const float i1 = 1.0f / hs1, i2 = 1.0f / hs2;
#pragma unroll
            for (int c = 0; c < 2; ++c)
#pragma unroll
                for (int d = 0; d < 2; ++d) {
                    unsigned a = 0, b = 0;
#pragma unroll
                    for (int j = 0; j < 8; ++j) {
                        const float x = hf[c][8 * d + j];
                        const float q1 = fminf(fmaxf(rintf(x * i1), -7.0f), 7.0f);
                        const float q2 = fminf(fmaxf(rintf((x - q1 * hs1) * i2), -7.0f), 7.0f);
                        a |= ((unsigned)(int)q1 & 0xFu) << (4 * j); b |= ((unsigned)(int)q2 & 0xFu) << (4 * j);
                    }
                    hq1[c][d] = a; hq2[c][d] = b;
                }
        }
#pragma unroll 1
        for (int hp = 0; hp < 4; ++hp) {
#pragma unroll
            for (int hh = 0; hh < 2; ++hh) {
                const float* sc = scores + (size_t)t * D + (hp * 2 + hh) * 256;
                const float v0a = sc[lane], v0b = sc[64 + lane], v1a = sc[128 + lane], v1b = sc[192 + lane];
                int k0a = (f2key(v0a) & ~127) | (127 - lane), k0b = (f2key(v0b) & ~127) | (63 - lane);
                int k1a = (f2key(v1a) & ~127) | (127 - lane), k1b = (f2key(v1b) & ~127) | (63 - lane);
                bitonic128(k0a, k0b, lane);
                bitonic128(k1a, k1b, lane);
                const int i0 = 127 - (k0a & 127), i1 = 127 - (k1a & 127);
                const float s0a = __shfl(v0a, i0 & 63), s0b = __shfl(v0b, i0 & 63), s1a = __shfl(v1a, i1 & 63), s1b = __shfl(v1b, i1 & 63);
                const float s0 = (i0 & 64) ? s0b : s0a, s1 = (i1 & 64) ? s1b : s1a;
                const float cval = __shfl(s0, ca) + __shfl(s1, cb);
                const int cexp = __shfl(i0, ca) * 128 + __shfl(i1, cb);
                int ck = cvalid ? ((f2key(cval) & ~63) | (63 - lane)) : (int)0x80000000;
                bitonic64(ck, lane);
                const int src = 63 - (ck & 63);
                const float tv = __shfl(cval, src);
                const int te = __shfl(cexp, src);
                const float mx = rdl(tv, 0);
                const float ew = lane < 16 ? __expf(rstd * (tv - mx)) : 0.f;
                float sum = ew;
                sum += shxf(sum, 8); sum += shxf(sum, 4); sum += shxf(sum, 2); sum += shxf(sum, 1);
                if (lane < 16) { wge[(hp * 2 + hh) * 16 + lane] = te; wgg[(hp * 2 + hh) * 16 + lane] = ew / sum; }
            }
        }
        f32x2 oacc2[2][8];
#pragma unroll
        for (int c = 0; c < 2; ++c)
#pragma unroll
            for (int j = 0; j < 8; ++j) oacc2[c][j] = (f32x2){0.f, 0.f};
#define PEER_LOAD(e_, ex_, gx_, uu_, vv_)                                                                                   \
        {                                                                                                                   \
            _Pragma("unroll") for (int k = 0; k < 4; ++k) { ex_[k] = __builtin_amdgcn_readfirstlane(wge[(e_) + k]); gx_[k] = wgg[(e_) + k]; } \
            _Pragma("unroll") for (int k = 0; k < 4; ++k) _Pragma("unroll") for (int c = 0; c < 2; ++c)                     \
                uu_[k][c] = *(const u32x2*)(Ub + (size_t)ex_[k] * 1024 + c * 512 + lane * 8);                                \
            _Pragma("unroll") for (int k = 0; k < 4; ++k) _Pragma("unroll") for (int c = 0; c < 2; ++c)                     \
                vv_[k][c] = *(const u32x2*)(Vb + (size_t)ex_[k] * 1024 + c * 512 + lane * 8);                                \
        }
#define PEER_COMPUTE(ex_, gx_, uu_, vv_)                                                                                    \
        {                                                                                                                   \
            float dd[4];                                                                                                    \
            _Pragma("unroll") for (int k = 0; k < 4; ++k) {                                                                 \
                int i1 = 0, i2 = 0;                                                                                         \
                _Pragma("unroll") for (int c = 0; c < 2; ++c) _Pragma("unroll") for (int q = 0; q < 2; ++q) {               \
                    const int w = (int)uu_[k][c][q];                                                                        \
                    i1 = __builtin_amdgcn_sdot8(w, (int)hq1[c][q], i1, false); i2 = __builtin_amdgcn_sdot8(w, (int)hq2[c][q], i2, false); \
                }                                                                                                           \
                dd[k] = (hs1 * (float)i1 + hs2 * (float)i2) * usc[ex_[k]];                                                  \
                __builtin_amdgcn_sched_barrier(0);                    \
            }                                                                                                               \
            _Pragma("unroll") for (int o = 32; o > 0; o >>= 1) { _Pragma("unroll") for (int k = 0; k < 4; ++k) dd[k] += shxf(dd[k], o); } \
            _Pragma("unroll") for (int k = 0; k < 4; ++k) {                                                                 \
                const float aa = gx_[k] * gelu_fast(dd[k] * rstd) * vsc[ex_[k]];                                     \
                const f32x2 ab = {aa, aa};                                                                                  \
                _Pragma("unroll") for (int c = 0; c < 2; ++c) _Pragma("unroll") for (int q = 0; q < 2; ++q) {               \
                    const unsigned w = vv_[k][c][q];                                                                        \
                    const f32x2 e0 = __builtin_amdgcn_cvt_scalef32_pk_f32_fp4(w, 1.0f, 0), e1 = __builtin_amdgcn_cvt_scalef32_pk_f32_fp4(w, 1.0f, 1); \
                    const f32x2 e2 = __builtin_amdgcn_cvt_scalef32_pk_f32_fp4(w, 1.0f, 2), e3 = __builtin_amdgcn_cvt_scalef32_pk_f32_fp4(w, 1.0f, 3); \
                    oacc2[c][4 * q] = ab * e0 + oacc2[c][4 * q]; oacc2[c][4 * q + 1] = ab * e1 + oacc2[c][4 * q + 1];       \
                    oacc2[c][4 * q + 2] = ab * e2 + oacc2[c][4 * q + 2]; oacc2[c][4 * q + 3] = ab * e3 + oacc2[c][4 * q + 3]; \
                }                                                                                                           \
                __builtin_amdgcn_sched_barrier(0);                                                                          \
            }                                                                                                               \
        }
        {
            int exA[4], exB[4]; float gxA[4], gxB[4];
            u32x2 uuA[4][2], uuB[4][2], vvA[4][2], vvB[4][2];
            PEER_LOAD(0, exA, gxA, uuA, vvA)
#pragma unroll 1
            for (int e = 0; e < 128; e += 8) {
                PEER_LOAD(e + 4, exB, gxB, uuB, vvB)
                PEER_COMPUTE(exA, gxA, uuA, vvA)
                if (e + 8 < 128) PEER_LOAD(e + 8, exA, gxA, uuA, vvA)
                PEER_COMPUTE(exB, gxB, uuB, vvB)
            }
        }
#undef PEER_LOAD
#undef PEER_COMPUTE
        f32x4 xr[2][4];
#pragma unroll
        for (int c = 0; c < 2; ++c)
#pragma unroll
            for (int q = 0; q < 4; ++q) xr[c][q] = *(const f32x4*)(yrow + c * 1024 + lane * 16 + 4 * q);
#pragma unroll
        for (int c = 0; c < 2; ++c)
#pragma unroll
            for (int q = 0; q < 4; ++q) {
                f32x4 xv = xr[c][q];
                xv[0] += oacc2[c][2 * q][0]; xv[1] += oacc2[c][2 * q][1]; xv[2] += oacc2[c][2 * q + 1][0]; xv[3] += oacc2[c][2 * q + 1][1];
                *(f32x4*)(yrow + c * 1024 + lane * 16 + 4 * q) = xv;
            }
    }
}

#define XB_TMO      128
#define XB_XCNT(j)  (256  + 64 * (j))
#define XB_XSUB(j)  (1280 + 64 * (j))
#define XB_XGEN(j)  (2304 + 64 * (j))
#define XB_TOP      3328
#define XB_TOPGEN   3392
#define XCD_BAR_WORDS 3456
#define XB_SPIN_CAP (1u << 18)
DI unsigned xb_ld(unsigned* p) { return __hip_atomic_load(p, __ATOMIC_RELAXED, __HIP_MEMORY_SCOPE_AGENT); }
DI unsigned xb_add(unsigned* p, unsigned v) { return __hip_atomic_fetch_add(p, v, __ATOMIC_RELAXED, __HIP_MEMORY_SCOPE_AGENT); }
DI unsigned xb_xcc_id() { return (unsigned)__builtin_amdgcn_s_getreg((3 << 11) | 20) & 0xFu; }
#define XB_SPIN(cond, bar) do { unsigned _sp = 0; while (cond) { __builtin_amdgcn_s_sleep(1); \
    if ((++_sp & 255u) == 0u) { if (xb_ld(&(bar)[XB_TMO])) break; if (_sp > XB_SPIN_CAP) { atomicAdd(&(bar)[XB_TMO], 1u); break; } } } } while (0)
struct XcdBarrier { unsigned* bar; unsigned x; volatile LDS3 unsigned* st; };
DI XcdBarrier xcd_barrier_post(unsigned* bar, volatile LDS3 unsigned* st) {
    XcdBarrier b; b.bar = bar; b.x = xb_xcc_id(); b.st = st;
    if (threadIdx.x == 0) (void)xb_add(&bar[XB_XCNT(b.x)], 1u);
    return b;
}
DI void xcd_barrier_complete(unsigned* bar, unsigned x, unsigned& nloc, unsigned& nx) {
    const unsigned G = gridDim.x * gridDim.y * gridDim.z;
    unsigned sum, cnt, mine, sp = 0u;
    for (;;) {
        sum = 0u; cnt = 0u; mine = 0u;
#pragma unroll
        for (unsigned j = 0; j < 16; ++j) { const unsigned c = xb_ld(&bar[XB_XCNT(j)]); sum += c; cnt += (c > 0u) ? 1u : 0u; mine = (j == x) ? c : mine; }
        if (sum == G) break;
        __builtin_amdgcn_s_sleep(1);
        if ((++sp & 255u) == 0u) { if (xb_ld(&bar[XB_TMO])) break; if (sp > XB_SPIN_CAP) { atomicAdd(&bar[XB_TMO], 1u); break; } }
    }
    nloc = mine > 0u ? mine : 1u; nx = cnt > 0u ? cnt : 1u;
}
DI void xcd_barrier(const XcdBarrier& b) {
    asm volatile("s_waitcnt vmcnt(0)" ::: "memory");
    __syncthreads();
    if (threadIdx.x == 0) {
        unsigned* bar = b.bar;
        __builtin_amdgcn_s_waitcnt(0);
        unsigned nloc = b.st[0], nx = b.st[1];
        if (nloc == 0u) { xcd_barrier_complete(bar, b.x, nloc, nx); b.st[0] = nloc; b.st[1] = nx; }
        const unsigned old = xb_add(&bar[XB_XSUB(b.x)], 1u);
        const unsigned gen = old / nloc;
        if (old + 1u == (gen + 1u) * nloc) {
            __builtin_amdgcn_fence(__ATOMIC_RELEASE, "agent");
            asm volatile("s_waitcnt vmcnt(0)" ::: "memory");
            const unsigned og = xb_add(&bar[XB_TOP], 1u);
            const unsigned tg = og / nx;
            if (og + 1u == (tg + 1u) * nx) xb_add(&bar[XB_TOPGEN], 1u);
            else XB_SPIN(xb_ld(&bar[XB_TOPGEN]) == tg, bar);
            __builtin_amdgcn_fence(__ATOMIC_ACQUIRE, "agent");
            xb_add(&bar[XB_XGEN(b.x)], 1u);
            asm volatile("s_waitcnt vmcnt(0)" ::: "memory");
        } else {
            XB_SPIN(xb_ld(&bar[XB_XGEN(b.x)]) == gen, bar);
            __builtin_amdgcn_fence(__ATOMIC_ACQUIRE, "agent");
            asm volatile("s_waitcnt vmcnt(0)" ::: "memory");
        }
    }
    __syncthreads();
}

__global__ void __launch_bounds__(256, 2) mega(Params p, int ph_lo, int ph_hi, int coop) {
    extern __shared__ __attribute__((aligned(16))) unsigned char smem[];
    __shared__ uint4 xb_words;
    if (threadIdx.x == 0) xb_words = make_uint4(0u, 0u, 0u, 0u);
    __syncthreads();
    XcdBarrier xb;
    xb.bar = nullptr; xb.x = 0; xb.st = nullptr;
    if (coop) xb = xcd_barrier_post((unsigned*)(p.ws + WS_BAR), (volatile LDS3 unsigned*)&xb_words);
    if (coop == 2) cg::this_grid().sync();
#define RUN_PHASE(k, fn)                                              \
    if (ph_lo <= (k) && (k) < ph_hi) {                                  \
        fn(p, smem);                                                    \
        if (coop && (k) + 1 < ph_hi) xcd_barrier(xb);                   \
    }
    RUN_PHASE(0, phase0)
    RUN_PHASE(1, phase1)
    RUN_PHASE(2, phase2)
    RUN_PHASE(3, phase3)
    RUN_PHASE(4, phase4)
    RUN_PHASE(5, phase5)
    RUN_PHASE(6, phase6)
    RUN_PHASE(8, phase8)
}

#ifndef N_LAUNCH_MODE
#define N_LAUNCH_MODE 1
#endif

extern "C" void kernel_launch(void* const* d_in, const int* in_sizes, int n_in, void* d_out, int out_size, void* d_ws, size_t ws_size, hipStream_t stream) {
    static int grid = 0;
    if (grid == 0) {
        int dev = 0, cus = 0, per_cu = 0;
        hipGetDevice(&dev);
        hipDeviceGetAttribute(&cus, hipDeviceAttributeMultiprocessorCount, dev);
        hipFuncSetAttribute((const void*)mega, hipFuncAttributeMaxDynamicSharedMemorySize, LDS_BYTES);
        hipOccupancyMaxActiveBlocksPerMultiprocessor(&per_cu, (const void*)mega, 256, LDS_BYTES);
        if (per_cu < 1) per_cu = 1;
        if (per_cu > 2) per_cu = 2;
        grid = cus * per_cu;
        if (n_in != 32 || ws_size < WS_END) { fprintf(stderr, "kernel_launch: unexpected n_in %d / ws_size %zu (need %zu)\n", n_in, ws_size, (size_t)WS_END); grid = -1; }
    }
    if (grid < 0) return;
    Params p{};
    for (int i = 0; i < 32; ++i) p.in[i] = (const float*)d_in[i];
    p.out = (float*)d_out;
    p.ws = (unsigned char*)d_ws;
    hipMemsetAsync((char*)d_ws + WS_CTL, 0, 32768, stream);
#if N_LAUNCH_MODE == 1
    int lo = 0, hi = 9, coop = 1;
    void* args[] = {&p, &lo, &hi, &coop};
    hipError_t e = hipLaunchCooperativeKernel((const void*)mega, dim3(grid), dim3(256), args, LDS_BYTES, stream);
    if (e != hipSuccess) fprintf(stderr, "cooperative launch failed: %s (grid %d)\n", hipGetErrorString(e), grid);
#else
    for (int ph = 0; ph < 9; ++ph) hipLaunchKernelGGL(mega, dim3(grid), dim3(256), LDS_BYTES, stream, p, ph, ph + 1, 0);
#endif
}
```

```cpp
#include <hip/hip_runtime.h>
#include <hip/hip_cooperative_groups.h>
#include <cstdint>
#include <cstdio>
namespace cg = cooperative_groups;

#define DI __device__ __forceinline__
typedef unsigned short bf16_t;
typedef short bf16x8 __attribute__((ext_vector_type(8)));
typedef short s16x4 __attribute__((ext_vector_type(4)));
typedef float f32x16 __attribute__((ext_vector_type(16)));
typedef float f32x4 __attribute__((ext_vector_type(4)));
typedef float f32x2 __attribute__((ext_vector_type(2)));
typedef unsigned u32x4 __attribute__((ext_vector_type(4)));
typedef unsigned u32x2 __attribute__((ext_vector_type(2)));
typedef __bf16 bf16v2 __attribute__((ext_vector_type(2)));
#define LDS3 __attribute__((address_space(3)))

constexpr int D = 2048, NP = 8192, NS = 512, MT = 8704, INW = 10752;
constexpr int OFF_Q = 0, OFF_K = 1024, OFF_V = 2048, OFF_U = 3072, OFF_VC = 3584, OFF_QM = 4096, OFF_G = 4608;
constexpr float EPS = 1e-6f;
constexpr float LOG2E = 1.4426950408889634f;
constexpr size_t O_Y = 0, O_KP = 17825792, O_VP = 26214400, O_MKP = 34603008, O_MVP = 35127296, O_KS = 35651584, O_VS = 36175872, O_CVS = 36700160;
constexpr size_t WS_CTL = 0;
constexpr size_t WS_BAR = 4096;
constexpr size_t WS_UB = 32768;
constexpr size_t WS_VB = WS_UB + 67108864;
constexpr size_t WS_P = WS_VB + 67108864;
constexpr size_t WS_WINT = WS_P + 187170816;
constexpr size_t WS_HB = WS_WINT + 44040192;
constexpr size_t WS_WMEMT = WS_HB + 35651584;
constexpr size_t WS_WBT = WS_WMEMT + 4194304;
constexpr size_t WS_WOT = WS_WBT + 8388608;
constexpr size_t WS_WQT = WS_WOT + 8388608;
constexpr size_t WS_MEMHB = WS_WQT + 8388608;
constexpr size_t WS_SKB = WS_MEMHB + 4194304;
constexpr size_t WS_KS = WS_SKB + 524288;
constexpr size_t WS_VS = WS_KS + 17825792;
constexpr size_t WS_MEMKV = WS_VS + 17825792;
constexpr size_t WS_MEMKB = WS_MEMKV + 4194304;
constexpr size_t WS_MEMVB = WS_MEMKB + 1048576;
constexpr size_t WS_CMK = WS_MEMVB + 1048576;
constexpr size_t WS_CMV = WS_CMK + 2097152;
constexpr size_t WS_VSC = WS_CMV + 2097152;
constexpr size_t WS_USC = WS_VSC + 65536;
constexpr size_t WS_ROPE = WS_USC + 65536;
constexpr size_t WS_END = WS_ROPE + 2112 * 8 * 8;
constexpr size_t WS_MIXIN = WS_WINT;
constexpr size_t WS_MERGED = WS_HB;
constexpr size_t WS_X1G = WS_WINT;
constexpr size_t WS_PEERQ = WS_HB;
constexpr size_t WS_SCORES = WS_P;

constexpr int LDS_BYTES = 73728;

struct Params {
    const float* in[32];
    float* out;
    unsigned char* ws;
};
enum { I_XP = 0, I_XS, I_MEMP, I_CDK, I_CDV, I_CMK, I_CMV, I_NMIXG, I_WIN, I_BGATE, I_QNG, I_KNG, I_LQ1, I_LK1, I_LQ2, I_LK2, I_OUTG,
       I_CMLNG, I_CMLNB, I_CMWS, I_CMBS, I_NMEMG, I_WMEMKV, I_MQNG, I_MKNG, I_WBR, I_WOUT, I_NFFNG, I_PWQ, I_PSK, I_PU, I_PV };

DI unsigned pk2(float lo, float hi) { f32x2 f = {lo, hi}; bf16v2 b = __builtin_convertvector(f, bf16v2); return __builtin_bit_cast(unsigned, b); }
DI bf16_t f2bf(float x) { return (bf16_t)(pk2(x, 0.f) & 0xffffu); }
DI float bflo(unsigned u) { return __uint_as_float(u << 16); }
DI float bfhi(unsigned u) { return __uint_as_float(u & 0xffff0000u); }
DI float bf2f(bf16_t b) { return __uint_as_float(((unsigned)b) << 16); }
DI void unpack8(u32x4 v, float* f) { f[0] = bflo(v.x); f[1] = bfhi(v.x); f[2] = bflo(v.y); f[3] = bfhi(v.y); f[4] = bflo(v.z); f[5] = bfhi(v.z); f[6] = bflo(v.w); f[7] = bfhi(v.w); }
DI u32x4 pack8(const float* f) { u32x4 r; r.x = pk2(f[0], f[1]); r.y = pk2(f[2], f[3]); r.z = pk2(f[4], f[5]); r.w = pk2(f[6], f[7]); return r; }
DI int shx(int v, int j) {
    switch (j) {
        case 1: return __builtin_amdgcn_update_dpp(0, v, 0xB1, 0xF, 0xF, true);
        case 2: return __builtin_amdgcn_update_dpp(0, v, 0x4E, 0xF, 0xF, true);
        case 4: return __builtin_amdgcn_update_dpp(0, __builtin_amdgcn_update_dpp(0, v, 0x141, 0xF, 0xF, true), 0x1B, 0xF, 0xF, true);
        case 8: return __builtin_amdgcn_update_dpp(0, v, 0x128, 0xF, 0xF, true);
        case 16: { const u32x2 r = __builtin_amdgcn_permlane16_swap((unsigned)v, (unsigned)v, false, false); return (threadIdx.x & 16) ? (int)r[0] : (int)r[1]; }
        default: { const u32x2 r = __builtin_amdgcn_permlane32_swap((unsigned)v, (unsigned)v, false, false); return (threadIdx.x & 32) ? (int)r[0] : (int)r[1]; }
    }
}
DI float shxf(float v, int j) { return __int_as_float(shx(__float_as_int(v), j)); }
DI float wave_sum(float v) {
#pragma unroll
    for (int o = 32; o > 0; o >>= 1) v += shxf(v, o);
    return v;
}
DI int opaque_tid() { int t = threadIdx.x; asm volatile("" : "+v"(t)); return t; }
DI int crow(int i, int h) { return (i & 3) + 8 * (i >> 2) + 4 * h; }
DI float gelu_exact(float x) { return 0.5f * x * (1.0f + erff(x * 0.70710678118654752f)); }
DI float gelu_fast(float v) {
    const float av = fabsf(v), t = __builtin_amdgcn_rcpf(av * 0.2316418882f + 1.0f);
    float q = t * 0.5307027145f + (-0.7265760135f); q = q * t + 0.7107068705f; q = q * t + (-0.142248368f); q = q * t + 0.127414796f; q = q * t;
    const float e = __builtin_amdgcn_exp2f((v * v) * (-0.72134752044f));
    const float m = v * (q * e);
    return v < 0.f ? m : v - m;
}
#define MFMA32(a, b, c) __builtin_amdgcn_mfma_f32_32x32x16_bf16((a), (b), (c), 0, 0, 0)
DI f32x16 zero16() { f32x16 z; for (int i = 0; i < 16; ++i) z[i] = 0.f; return z; }
DI bf16x8 tr_pair(const unsigned char* lo, const unsigned char* hi) {
    s16x4 a = __builtin_amdgcn_ds_read_tr16_b64_v4i16((LDS3 s16x4*)lo);
    s16x4 b = __builtin_amdgcn_ds_read_tr16_b64_v4i16((LDS3 s16x4*)hi);
    return __builtin_shufflevector(a, b, 0, 1, 2, 3, 4, 5, 6, 7);
}

#define SGPR(x) __builtin_amdgcn_readfirstlane(x)
template <class F> DI void for_tiles(int TM, int TN, F f) {
    const int T = TM * TN, G = gridDim.x, bid = blockIdx.x;
    const int nx = (G % 8 == 0) ? 8 : 1;
    const int xcd = SGPR(bid % nx), idx = SGPR(bid / nx), per = SGPR(G / nx);
    const int chunk = SGPR((T + nx - 1) / nx);
    for (int v = idx; v < chunk; v += per) {
        const int id = xcd * chunk + v;
        if (id >= T) break;
        const int gsize = 8 * TN, g = SGPR(id / gsize), rem = id - g * gsize;
        const int mrows = (TM - 8 * g) < 8 ? (TM - 8 * g) : 8;
        const int tn = SGPR(rem / mrows), tm = 8 * g + (rem - tn * mrows);
        f(tm, tn);
    }
}

#define GLB1 __attribute__((address_space(1)))
template <int N> DI void wait_vm() {
    if constexpr (N == 0) asm volatile("s_waitcnt vmcnt(0)" ::: "memory");
    else if constexpr (N == 3) asm volatile("s_waitcnt vmcnt(3)" ::: "memory");
    else if constexpr (N == 4) asm volatile("s_waitcnt vmcnt(4)" ::: "memory");
    else if constexpr (N == 6) asm volatile("s_waitcnt vmcnt(6)" ::: "memory");
    else if constexpr (N == 8) asm volatile("s_waitcnt vmcnt(8)" ::: "memory");
    else if constexpr (N == 12) asm volatile("s_waitcnt vmcnt(12)" ::: "memory");
    else if constexpr (N == 16) asm volatile("s_waitcnt vmcnt(16)" ::: "memory");
    else static_assert(N == 0, "add the count");
}
template <int MI, int NST>
DI void gemm_kloop(f32x16 (&acc)[MI][2], const bf16_t* __restrict__ Ag, int lda, const bf16_t* __restrict__ Bg, int ldb, int nk  , unsigned char* smem) {
    constexpr int AROWS = 64 * MI, A_BYTES = AROWS * 64, STAGE = A_BYTES + 128 * 64, AL = MI  , BL = 2, LPW = AL + BL;
    static_assert(NST >= 3 && NST * STAGE <= 73728, "ring does not fit");
    const int tid = opaque_tid(), lane = tid & 63, wave = tid >> 6, wm = wave >> 1, wn = wave & 1, r = lane & 31, h = lane >> 5;
    const int frow = lane >> 2, fslot = lane & 3;
    const int kcs = (fslot ^ ((frow >> 2) & 3)) * 8;
    const int aoff0 = (wave * AL * 16 + frow) * lda + kcs, boff0 = (wave * BL * 16 + frow) * ldb + kcs;
    unsigned char* afill = smem + wave * AL * 1024;
    unsigned char* bfill = smem + A_BYTES + wave * BL * 1024;
#define GEMM_FILL(slot_, kt_)                                                                                                        \
    {                                                                                                                                \
        _Pragma("unroll") for (int i = 0; i < AL; ++i)                                                                               \
            __builtin_amdgcn_global_load_lds((GLB1 const void*)(Ag + (size_t)(i * 16) * lda + (kt_) * 32 + aoff0), (LDS3 void*)(afill + (slot_) * STAGE + i * 1024), 16, 0, 0); \
        _Pragma("unroll") for (int i = 0; i < BL; ++i)                                                                               \
            __builtin_amdgcn_global_load_lds((GLB1 const void*)(Bg + (size_t)(i * 16) * ldb + (kt_) * 32 + boff0), (LDS3 void*)(bfill + (slot_) * STAGE + i * 1024), 16, 0, 0); \
    }
#pragma unroll
    for (int t = 0; t < NST - 1; ++t) GEMM_FILL(t, t)
    const int sw = (r >> 2) & 3;
    const int k0off = ((0 + h) ^ sw) * 16, k1off = ((2 + h) ^ sw) * 16;
    const int a_rd = (wm * 32 * MI + r) * 64;
    const int b_rd = A_BYTES + (wn * 64 + r) * 64;
    int slot = 0;
    for (int kt = 0; kt < nk; ++kt) {
        const int rem = nk - 1 - kt;
        if (rem >= NST - 2) wait_vm<(NST - 2) * LPW>();
        else if (NST >= 4 && rem == 2) wait_vm<2 * LPW>();
        else if (rem == 1) wait_vm<LPW>();
        else wait_vm<0>();
        __builtin_amdgcn_s_barrier();
        asm volatile("" ::: "memory");
        if (kt + NST - 1 < nk) { const int fs = slot == 0 ? NST - 1 : slot - 1; GEMM_FILL(fs, kt + NST - 1) }
        const unsigned char* st = smem + slot * STAGE;
#pragma unroll
        for (int ks = 0; ks < 2; ++ks) {
            const int ko = ks == 0 ? k0off : k1off;
            bf16x8 b[2];
#pragma unroll
            for (int ni = 0; ni < 2; ++ni) b[ni] = *(const bf16x8*)(st + b_rd + ni * 32 * 64 + ko);
            constexpr int MS = MI >= 2 ? 2 : 1;
#pragma unroll
            for (int m0 = 0; m0 < MI; m0 += MS) {
                bf16x8 a[MS];
#pragma unroll
                for (int mi = 0; mi < MS; ++mi) a[mi] = *(const bf16x8*)(st + a_rd + (m0 + mi) * 32 * 64 + ko);
                __builtin_amdgcn_s_setprio(1);
#pragma unroll
                for (int mi = 0; mi < MS; ++mi)
#pragma unroll
                    for (int ni = 0; ni < 2; ++ni) acc[m0 + mi][ni] = MFMA32(a[mi], b[ni], acc[m0 + mi][ni]);
                __builtin_amdgcn_s_setprio(0);
            }
        }
        slot = slot + 1 == NST ? 0 : slot + 1;
    }
    __syncthreads();
#undef GEMM_FILL
}
#define EPI_FOR(MI_, acc_, BODY)                                                                             \
    {                                                                                                        \
        const int tid_ = opaque_tid(), lane_ = tid_ & 63, wave_ = tid_ >> 6, r_ = lane_ & 31, h_ = lane_ >> 5; \
        _Pragma("unroll") for (int mi_ = 0; mi_ < (MI_); ++mi_) _Pragma("unroll") for (int ni_ = 0; ni_ < 2; ++ni_) { \
            _Pragma("unroll") for (int i_ = 0; i_ < 16; ++i_) {                                              \
            const int row = (wave_ >> 1) * 32 * (MI_) + mi_ * 32 + crow(i_, h_);                             \
            const int col = (wave_ & 1) * 64 + ni_ * 32 + r_;                                                \
            const float v = acc_[mi_][ni_][i_];                                                              \
            BODY                                                                                             \
            if ((i_ & 3) == 3) asm volatile("" ::: "memory");     \
            }                                                                                                \
        }                                                                                                    \
    }

#define EPI_STORE_BF16(MI_, acc_, optr_, ld_)                                                                 \
    {                                                                                                        \
        const int tid_ = opaque_tid(), lane_ = tid_ & 63, wave_ = tid_ >> 6, r_ = lane_ & 31, h_ = lane_ >> 5; \
        const bool odd_ = (r_ & 1) != 0;                                                                     \
        _Pragma("unroll") for (int mi_ = 0; mi_ < (MI_); ++mi_) _Pragma("unroll") for (int ni_ = 0; ni_ < 2; ++ni_) \
            _Pragma("unroll") for (int i_ = 0; i_ < 16; i_ += 2) {                                           \
            const float a0_ = acc_[mi_][ni_][i_], a1_ = acc_[mi_][ni_][i_ + 1];                              \
            const float recv_ = shxf(odd_ ? a0_ : a1_, 1);                                                   \
            const int row_ = (wave_ >> 1) * 32 * (MI_) + mi_ * 32 + crow(i_ + (odd_ ? 1 : 0), h_);           \
            const int col_ = (wave_ & 1) * 64 + ni_ * 32 + (r_ & ~1);                                        \
            *(unsigned*)((optr_) + row_ * (ld_) + col_) = odd_ ? pk2(recv_, a1_) : pk2(a0_, recv_);          \
        }                                                                                                    \
    }

DI void rmsnorm_row_to_bf16(const float* x, const float* g, bf16_t* o, int lane) {
    f32x4 v[8], gq[8];
    float ss = 0.f;
#pragma unroll
    for (int c = 0; c < 8; ++c) { v[c] = *(const f32x4*)(x + c * 256 + lane * 4); gq[c] = *(const f32x4*)(g + c * 256 + lane * 4); }
#pragma unroll
    for (int c = 0; c < 8; ++c) ss += v[c][0] * v[c][0] + v[c][1] * v[c][1] + v[c][2] * v[c][2] + v[c][3] * v[c][3];
    ss = wave_sum(ss);
    const float rstd = rsqrtf(ss * (1.0f / 2048.0f) + EPS);
#pragma unroll
    for (int c = 0; c < 8; ++c) {
        const f32x4 gg = gq[c];
        u32x2 w; w.x = pk2(v[c][0] * rstd * gg[0], v[c][1] * rstd * gg[1]); w.y = pk2(v[c][2] * rstd * gg[2], v[c][3] * rstd * gg[3]);
        *(u32x2*)(o + c * 256 + lane * 4) = w;
    }
}
DI void transpose_tile(const float* W, int N, bf16_t* WT, int kt, int nt, unsigned char* smem) {
    float* tile = (float*)smem;
    const int tid = threadIdx.x;
#pragma unroll
    for (int i = 0; i < 4; ++i) {
        const int k = (tid >> 4) + 16 * i, n4 = (tid & 15) * 4;
        const f32x4 v = *(const f32x4*)(W + (size_t)(kt * 64 + k) * N + nt * 64 + n4);
        tile[k * 65 + n4 + 0] = v[0]; tile[k * 65 + n4 + 1] = v[1]; tile[k * 65 + n4 + 2] = v[2]; tile[k * 65 + n4 + 3] = v[3];
    }
    __syncthreads();
#pragma unroll
    for (int i = 0; i < 2; ++i) {
        const int n = (tid >> 3) + 32 * i, kc = (tid & 7) * 8;
        float f[8];
#pragma unroll
        for (int j = 0; j < 8; ++j) f[j] = tile[(kc + j) * 65 + n];
        *(u32x4*)(WT + (size_t)(nt * 64 + n) * 2048 + kt * 64 + kc) = pack8(f);
    }
    __syncthreads();
}
DI void convert_job(const float* src, bf16_t* dst, int job) {
    const int tid = threadIdx.x;
    f32x4 a[4], b[4];
#pragma unroll
    for (int i = 0; i < 4; ++i) { const size_t idx = (size_t)job * 8192 + i * 2048 + tid * 8; a[i] = *(const f32x4*)(src + idx); b[i] = *(const f32x4*)(src + idx + 4); }
#pragma unroll
    for (int i = 0; i < 4; ++i) {
        const size_t idx = (size_t)job * 8192 + i * 2048 + tid * 8;
        u32x4 w; w.x = pk2(a[i][0], a[i][1]); w.y = pk2(a[i][2], a[i][3]); w.z = pk2(b[i][0], b[i][1]); w.w = pk2(b[i][2], b[i][3]);
        *(u32x4*)(dst + idx) = w;
    }
}
DI void convert8_job(const float* src, unsigned char* dst, int job, float scale) {
    const int tid = threadIdx.x;
#pragma unroll
    for (int i = 0; i < 2; ++i) {
        const size_t idx = (size_t)job * 8192 + i * 4096 + tid * 16;
        u32x4 w;
#pragma unroll
        for (int q = 0; q < 4; ++q) {
            const f32x4 a = *(const f32x4*)(src + idx + 4 * q);
            int t = 0;
            t = __builtin_amdgcn_cvt_pk_fp8_f32(a[0] * scale, a[1] * scale, t, false);
            t = __builtin_amdgcn_cvt_pk_fp8_f32(a[2] * scale, a[3] * scale, t, true);
            w[q] = (unsigned)t;
        }
        *(u32x4*)(dst + idx) = w;
    }
}
DI void convert4_rows(const float* src, unsigned char* dst, float* rowscale, int job) {
    const int tid = threadIdx.x, lane = tid & 63, wave = tid >> 6;
    const int row = job * 4 + wave;
    const float* sp = src + (size_t)row * D;
    f32x4 v[2][4];
    float am = 0.f;
#pragma unroll
    for (int c = 0; c < 2; ++c)
#pragma unroll
        for (int q = 0; q < 4; ++q) {
            v[c][q] = *(const f32x4*)(sp + c * 1024 + lane * 16 + 4 * q);
            am = fmaxf(am, fmaxf(fmaxf(fabsf(v[c][q][0]), fabsf(v[c][q][1])), fmaxf(fabsf(v[c][q][2]), fabsf(v[c][q][3]))));
        }
#pragma unroll
    for (int o = 32; o > 0; o >>= 1) am = fmaxf(am, shxf(am, o));
    const float sc = am > 0.f ? am * (1.0f / 6.0f) : 1.0f, inv = 1.0f / sc;
    if (lane == 0) rowscale[row] = sc;
#pragma unroll
    for (int c = 0; c < 2; ++c) {
        u32x2 w;
#pragma unroll
        for (int d = 0; d < 2; ++d) {
            unsigned t = 0;
            const f32x4 a = v[c][2 * d], b = v[c][2 * d + 1];
            t = __builtin_amdgcn_cvt_scalef32_pk_fp4_f32(t, a[0] * inv, a[1] * inv, 1.0f, 0);
            t = __builtin_amdgcn_cvt_scalef32_pk_fp4_f32(t, a[2] * inv, a[3] * inv, 1.0f, 1);
            t = __builtin_amdgcn_cvt_scalef32_pk_fp4_f32(t, b[0] * inv, b[1] * inv, 1.0f, 2);
            t = __builtin_amdgcn_cvt_scalef32_pk_fp4_f32(t, b[2] * inv, b[3] * inv, 1.0f, 3);
            w[d] = t;
        }
        *(u32x2*)(dst + (size_t)row * 1024 + c * 512 + lane * 8) = w;
    }
}
DI void convert_i4_rows(const float* src, unsigned char* dst, float* rowscale, int job) {
    const int tid = threadIdx.x, lane = tid & 63, wave = tid >> 6;
    const int row = job * 4 + wave;
    const float* sp = src + (size_t)row * D;
    f32x4 v[2][4];
    float am = 0.f;
#pragma unroll
    for (int c = 0; c < 2; ++c)
#pragma unroll
        for (int q = 0; q < 4; ++q) {
            v[c][q] = *(const f32x4*)(sp + c * 1024 + lane * 16 + 4 * q);
            am = fmaxf(am, fmaxf(fmaxf(fabsf(v[c][q][0]), fabsf(v[c][q][1])), fmaxf(fabsf(v[c][q][2]), fabsf(v[c][q][3]))));
        }
#pragma unroll
    for (int o = 32; o > 0; o >>= 1) am = fmaxf(am, shxf(am, o));
    const float sc = am > 0.f ? am * (1.0f / 7.0f) : 1.0f, inv = 1.0f / sc;
    if (lane == 0) rowscale[row] = sc;
#pragma unroll
    for (int c = 0; c < 2; ++c) {
        u32x2 w;
#pragma unroll
        for (int d = 0; d < 2; ++d) {
            unsigned t = 0;
#pragma unroll
            for (int j = 0; j < 8; ++j) {
                const float x = v[c][2 * d + (j >> 2)][j & 3] * inv;
                const int qi = (int)fminf(fmaxf(rintf(x), -7.0f), 7.0f);
                t |= ((unsigned)qi & 0xFu) << (4 * j);
            }
            w[d] = t;
        }
        *(u32x2*)(dst + (size_t)row * 1024 + c * 512 + lane * 8) = w;
    }
}
DI void phase0(const Params& p, unsigned char* smem) {
    const int tid = threadIdx.x, lane = tid & 63, wave = tid >> 6;
    unsigned char* ws = p.ws;
    constexpr int J_NORM = 2432, J_TR = 8960, J_CV = 10528 - 8192, J_ROPE = 66, J_ALL = J_NORM + J_TR + J_CV + J_ROPE;
    for (int job = blockIdx.x; job < J_ALL; job += gridDim.x) {
        if (job >= J_NORM + J_TR + J_CV) {
            const int idx = (job - (J_NORM + J_TR + J_CV)) * 256 + tid;
            const int pos = idx >> 3, i = idx & 7;
            const float inv = exp2f(-(float)i * (18.931568569324174f / 8.0f));
            float sn, cs; sincosf((float)pos * inv, &sn, &cs);
            ((f32x2*)(ws + WS_ROPE))[idx] = (f32x2){cs, sn};
            continue;
        }
        if (job < J_NORM) {
            const int row = job * 4 + wave;
            if (row < MT) {
                const float* x = row < NP ? p.in[I_XP] + (size_t)row * D : p.in[I_XS] + (size_t)(row - NP) * D;
                rmsnorm_row_to_bf16(x, p.in[I_NMIXG], (bf16_t*)(ws + WS_HB) + (size_t)row * D, lane);
            } else {
                const int mr = row - MT;
                rmsnorm_row_to_bf16(p.in[I_MEMP] + (size_t)mr * D, p.in[I_NMEMG], (bf16_t*)(ws + WS_MEMHB) + (size_t)mr * D, lane);
            }
        } else if (job < J_NORM + J_TR) {
            int j = job - J_NORM;
            if (j < 5376) { transpose_tile(p.in[I_WIN], INW, (bf16_t*)(ws + WS_WINT), j / 168, j % 168, smem); }
            else if (j < 5376 + 512) { j -= 5376; transpose_tile(p.in[I_WMEMKV], 1024, (bf16_t*)(ws + WS_WMEMT), j / 16, j % 16, smem); }
            else if (j < 5888 + 1024) { j -= 5888; transpose_tile(p.in[I_WBR], 2048, (bf16_t*)(ws + WS_WBT), j / 32, j % 32, smem); }
            else if (j < 6912 + 1024) { j -= 6912; transpose_tile(p.in[I_WOUT], 2048, (bf16_t*)(ws + WS_WOT), j / 32, j % 32, smem); }
            else { j -= 7936; transpose_tile(p.in[I_PWQ], 2048, (bf16_t*)(ws + WS_WQT), j / 32, j % 32, smem); }
        } else {
            int j = job - J_NORM - J_TR + 8192;
            if (j < 8192) {   }
            else if (j < 9216) { j -= 8192; const int b = j >> 7, jj = j & 127; convert_job(p.in[I_CDK] + (size_t)b * 1048576, (bf16_t*)(ws + WS_KS) + (size_t)b * 1088 * 1024, jj); }
            else if (j < 10240) { j -= 9216; const int b = j >> 7, jj = j & 127; convert_job(p.in[I_CDV] + (size_t)b * 1048576, (bf16_t*)(ws + WS_VS) + (size_t)b * 1088 * 1024, jj); }
            else if (j < 10368) convert_job(p.in[I_CMK], (bf16_t*)(ws + WS_CMK), j - 10240);
            else if (j < 10496) convert_job(p.in[I_CMV], (bf16_t*)(ws + WS_CMV), j - 10368);
            else convert_job(p.in[I_PSK], (bf16_t*)(ws + WS_SKB), j - 10496);
        }
    }
}

DI void phase1(const Params& p, unsigned char* smem) {
    unsigned char* ws = p.ws;
    const bf16_t* Hb = (const bf16_t*)(ws + WS_HB);
    const bf16_t* WinT = (const bf16_t*)(ws + WS_WINT);
    bf16_t* P = (bf16_t*)(ws + WS_P);
    for_tiles(34, 84, [&](int tm, int tn) {
        f32x16 acc[4][2];
#pragma unroll
        for (int mi = 0; mi < 4; ++mi) acc[mi][0] = acc[mi][1] = zero16();
        gemm_kloop<4, 3>(acc, Hb + (size_t)tm * 256 * D, D, WinT + (size_t)tn * 128 * D, D, 64, smem);
        bf16_t* o = P + (size_t)tm * 256 * INW + tn * 128;
        EPI_STORE_BF16(4, acc, o, INW)
    });
    const bf16_t* MemHb = (const bf16_t*)(ws + WS_MEMHB);
    const bf16_t* WmemT = (const bf16_t*)(ws + WS_WMEMT);
    float* MemKV = (float*)(ws + WS_MEMKV);
    for (int t = gridDim.x - 1 - blockIdx.x; t < 32; t += gridDim.x) {
        const int tm = t >> 3, tn = t & 7;
        f32x16 acc[4][2];
#pragma unroll
        for (int mi = 0; mi < 4; ++mi) acc[mi][0] = acc[mi][1] = zero16();
        gemm_kloop<4, 3>(acc, MemHb + (size_t)tm * 256 * D, D, WmemT + (size_t)tn * 128 * D, D, 64, smem);
        float* o = MemKV + (size_t)tm * 256 * 1024 + tn * 128;
        EPI_FOR(4, acc, { o[row * 1024 + col] = v; })
    }
}

DI void qk_norm_rope(float* v, f32x4 g0, f32x4 g1, int gl, const float* cs, const float* sn, float scale) {
    float ss = 0.f;
#pragma unroll
    for (int i = 0; i < 8; ++i) ss += v[i] * v[i];
    ss += shxf(ss, 1); ss += shxf(ss, 2); ss += shxf(ss, 4);
    const float rstd = rsqrtf(ss * (1.0f / 64.0f) + EPS);
    float y[8];
#pragma unroll
    for (int i = 0; i < 4; ++i) { y[i] = v[i] * rstd * g0[i]; y[4 + i] = v[4 + i] * rstd * g1[i]; }
#pragma unroll
    for (int i = 0; i < 8; ++i) {
        const float pr = shxf(y[i], 1);
        float o = y[i];
        if (gl == 0) o = y[i] * cs[i] - pr * sn[i];
        else if (gl == 1) o = y[i] * cs[i] + pr * sn[i];
        v[i] = o * scale;
    }
}
DI void phase2(const Params& p, unsigned char* smem) {
    const int tid = threadIdx.x, lane = tid & 63, wave = tid >> 6;
    unsigned char* ws = p.ws;
    bf16_t* P = (bf16_t*)(ws + WS_P);
    float* out = p.out;
    constexpr int J_TOK = 2176, J_MEM = 256;
    for (int job = blockIdx.x; job < J_TOK + J_MEM; job += gridDim.x) {
        if (job < J_TOK) {
            const int row = job * 4 + wave;
            const bool samp = row >= NP;
            const int rs = row - NP;
            const int pos = samp ? 1024 + (rs & 63) : (row & 2047);
            bf16_t* pr = P + (size_t)row * INW;
            u32x4 in[9];
#pragma unroll
            for (int c = 0; c < 9; ++c) in[c] = *(const u32x4*)(pr + c * 512 + lane * 8);
            float cs[8], sn[8];
            {
                const f32x4* rt = (const f32x4*)(ws + WS_ROPE) + pos * 4;
#pragma unroll
                for (int i = 0; i < 4; ++i) { const f32x4 v = rt[i]; cs[2 * i] = v[0]; sn[2 * i] = v[1]; cs[2 * i + 1] = v[2]; sn[2 * i + 1] = v[3]; }
            }
            const int gl = lane & 7;
            const f32x4 qg0 = *(const f32x4*)(p.in[I_QNG] + gl * 8), qg1 = *(const f32x4*)(p.in[I_QNG] + gl * 8 + 4);
            const f32x4 kg0 = *(const f32x4*)(p.in[I_KNG] + gl * 8), kg1 = *(const f32x4*)(p.in[I_KNG] + gl * 8 + 4);
            const f32x4 lg0 = *(const f32x4*)(p.in[I_CMLNG] + lane * 8), lg1 = *(const f32x4*)(p.in[I_CMLNG] + lane * 8 + 4);
            const f32x4 lb0 = *(const f32x4*)(p.in[I_CMLNB] + lane * 8), lb1 = *(const f32x4*)(p.in[I_CMLNB] + lane * 8 + 4);
            const f32x4 mg0 = *(const f32x4*)(p.in[I_MQNG] + (lane & 15) * 8), mg1 = *(const f32x4*)(p.in[I_MQNG] + (lane & 15) * 8 + 4);
#pragma unroll
            for (int ps = 0; ps < 2; ++ps) {
                float f[8]; unpack8(in[ps], f);
                qk_norm_rope(f, qg0, qg1, gl, cs, sn, 0.125f * LOG2E);
                *(u32x4*)(pr + OFF_Q + ps * 512 + lane * 8) = pack8(f);
            }
#pragma unroll
            for (int ps = 0; ps < 2; ++ps) {
                const int c = ps * 512 + lane * 8;
                float f[8]; unpack8(in[2 + ps], f);
                qk_norm_rope(f, kg0, kg1, gl, cs, sn, 1.0f);
                float* ko = samp ? out + O_KS + (size_t)rs * 1024 + c : out + O_KP + (size_t)row * 1024 + c;
                *(f32x4*)ko = (f32x4){f[0], f[1], f[2], f[3]};
                *(f32x4*)(ko + 4) = (f32x4){f[4], f[5], f[6], f[7]};
                const u32x4 w = pack8(f);
                if (samp) *(u32x4*)((bf16_t*)(ws + WS_KS) + ((size_t)(rs >> 6) * 1088 + 1024 + (rs & 63)) * 1024 + c) = w;
                else *(u32x4*)(pr + OFF_K + c) = w;
            }
#pragma unroll
            for (int ps = 0; ps < 2; ++ps) {
                const int c = ps * 512 + lane * 8;
                const u32x4 w = in[4 + ps];
                float f[8]; unpack8(w, f);
                float* vo = samp ? out + O_VS + (size_t)rs * 1024 + c : out + O_VP + (size_t)row * 1024 + c;
                *(f32x4*)vo = (f32x4){f[0], f[1], f[2], f[3]};
                *(f32x4*)(vo + 4) = (f32x4){f[4], f[5], f[6], f[7]};
                if (samp) *(u32x4*)((bf16_t*)(ws + WS_VS) + ((size_t)(rs >> 6) * 1088 + 1024 + (rs & 63)) * 1024 + c) = w;
            }
            {
                float f[8]; unpack8(in[6], f);
#pragma unroll
                for (int i = 0; i < 8; ++i) f[i] = gelu_fast(f[i]);
                *(u32x4*)(pr + OFF_U + lane * 8) = pack8(f);
            }
            {
                const int c = lane * 8;
                float f[8]; unpack8(in[7], f);
                float sm = 0.f;
#pragma unroll
                for (int i = 0; i < 8; ++i) { f[i] = gelu_fast(f[i]); sm += f[i]; }
                const float mu = wave_sum(sm) * (1.0f / 512.0f);
                float q = 0.f;
#pragma unroll
                for (int i = 0; i < 8; ++i) { f[i] -= mu; q += f[i] * f[i]; }
                const float rstd = rsqrtf(wave_sum(q) * (1.0f / 512.0f) + EPS);
#pragma unroll
                for (int i = 0; i < 4; ++i) { f[i] = f[i] * rstd * lg0[i] + lb0[i]; f[4 + i] = f[4 + i] * rstd * lg1[i] + lb1[i]; }
                *(u32x4*)(pr + OFF_VC + c) = pack8(f);
                if (samp) {
                    float* co = out + O_CVS + (size_t)rs * 512 + c;
                    *(f32x4*)co = (f32x4){f[0], f[1], f[2], f[3]};
                    *(f32x4*)(co + 4) = (f32x4){f[4], f[5], f[6], f[7]};
                }
            }
            {
                float f[8]; unpack8(in[8], f);
                float ss = 0.f;
#pragma unroll
                for (int i = 0; i < 8; ++i) ss += f[i] * f[i];
                ss += shxf(ss, 1); ss += shxf(ss, 2); ss += shxf(ss, 4); ss += shxf(ss, 8);
                const float rstd = rsqrtf(ss * (1.0f / 128.0f) + EPS) * (0.08838834764831845f * LOG2E);
#pragma unroll
                for (int i = 0; i < 4; ++i) { f[i] = f[i] * rstd * mg0[i]; f[4 + i] = f[4 + i] * rstd * mg1[i]; }
                *(u32x4*)(pr + OFF_QM + lane * 8) = pack8(f);
            }
        } else {
            const int row = (job - J_TOK) * 4 + wave;
            const float* src = (const float*)(ws + WS_MEMKV) + (size_t)row * 1024;
            {
                const int c = lane * 8;
                const f32x4 a = *(const f32x4*)(src + c), b = *(const f32x4*)(src + c + 4);
                float f[8] = {a[0], a[1], a[2], a[3], b[0], b[1], b[2], b[3]};
                float ss = 0.f;
#pragma unroll
                for (int i = 0; i < 8; ++i) ss += f[i] * f[i];
                ss += shxf(ss, 1); ss += shxf(ss, 2); ss += shxf(ss, 4); ss += shxf(ss, 8);
                const float rstd = rsqrtf(ss * (1.0f / 128.0f) + EPS);
                const float* g = p.in[I_MKNG] + (lane & 15) * 8;
#pragma unroll
                for (int i = 0; i < 8; ++i) f[i] = f[i] * rstd * g[i];
                float* ko = out + O_MKP + (size_t)row * 512 + c;
                *(f32x4*)ko = (f32x4){f[0], f[1], f[2], f[3]};
                *(f32x4*)(ko + 4) = (f32x4){f[4], f[5], f[6], f[7]};
                *(u32x4*)((bf16_t*)(ws + WS_MEMKB) + (size_t)row * 512 + c) = pack8(f);
            }
            {
                const int c = lane * 8;
                const f32x4 a = *(const f32x4*)(src + 512 + c), b = *(const f32x4*)(src + 512 + c + 4);
                float f[8] = {a[0], a[1], a[2], a[3], b[0], b[1], b[2], b[3]};
                float* vo = out + O_MVP + (size_t)row * 512 + c;
                *(f32x4*)vo = a; *(f32x4*)(vo + 4) = b;
                *(u32x4*)((bf16_t*)(ws + WS_MEMVB) + (size_t)row * 512 + c) = pack8(f);
            }
        }
    }
}

template <int DQK, int KW, bool PF>
DI void attn_main(const bf16_t* Qw, int qstride, const bf16_t* Kg, size_t kstride, const bf16_t* Vg, size_t vstride, int nkt, int kcol, int vcol,
                  unsigned char* smem, f32x16 (&o)[4], float& m_run, float& l_run) {
    constexpr int KROW = KW * 2 + 16, VROW = KW * 2 + 32, VOFF = 64 * KROW, CPR = KW / 8, NCH = KW / 32, NKS = DQK / 16;
    const int tid = opaque_tid(), lane = tid & 63, r = lane & 31, h = lane >> 5;
    bf16x8 qf[NKS];
#pragma unroll
    for (int ks = 0; ks < NKS; ++ks) qf[ks] = *(const bf16x8*)(Qw + (size_t)r * qstride + ks * 16 + h * 8);
#pragma unroll
    for (int dt = 0; dt < 4; ++dt) o[dt] = zero16();
    m_run = -INFINITY; l_run = 0.f;
    u32x4 rk[NCH], rv[PF ? NCH : 1];
    constexpr int RPI = 256 / CPR;
    const unsigned kvo = (unsigned)((tid / CPR) * (int)kstride * 2 + (tid % CPR) * 16);
    const unsigned vvo = (unsigned)((tid / CPR) * (int)vstride * 2 + (tid % CPR) * 16);
    const int wlo = (tid / CPR) * KROW + (tid % CPR) * 16, wlv = VOFF + (tid / CPR) * VROW + (tid % CPR) * 16;
    if (PF) {
#pragma unroll
        for (int i = 0; i < NCH; ++i) { rk[i] = *(const u32x4*)((const char*)(Kg + (size_t)(i * RPI) * kstride) + kvo); rv[i] = *(const u32x4*)((const char*)(Vg + (size_t)(i * RPI) * vstride) + vvo); }
    }
    const int gi = lane >> 4, i16 = lane & 15, tq = i16 >> 2, tp = i16 & 3;
    const unsigned char* vbase = smem + VOFF + (4 * h + tq) * VROW + (vcol + 16 * (gi & 1)) * 2 + 8 * tp;
    const unsigned char* kbase = smem + r * KROW + (kcol + h * 8) * 2;
#pragma unroll 1
    for (int kt = 0; kt < nkt; ++kt) {
        if (!PF) {
#pragma unroll
            for (int i = 0; i < NCH; ++i) rk[i] = *(const u32x4*)((const char*)(Kg + (size_t)(kt * 64 + i * RPI) * kstride) + kvo);
        }
        __syncthreads();
        if (PF) {
#pragma unroll
            for (int i = 0; i < NCH; ++i) { *(u32x4*)(smem + wlo + i * RPI * KROW) = rk[i]; *(u32x4*)(smem + wlv + i * RPI * VROW) = rv[i]; }
        } else {
#pragma unroll
            for (int i = 0; i < NCH; ++i) *(u32x4*)(smem + wlo + i * RPI * KROW) = rk[i];
#pragma unroll
            for (int i = 0; i < NCH; ++i) rk[i] = *(const u32x4*)((const char*)(Vg + (size_t)(kt * 64 + i * RPI) * vstride) + vvo);
#pragma unroll
            for (int i = 0; i < NCH; ++i) *(u32x4*)(smem + wlv + i * RPI * VROW) = rk[i];
        }
        __syncthreads();
        if (PF && kt + 1 < nkt) {
#pragma unroll
            for (int i = 0; i < NCH; ++i) { rk[i] = *(const u32x4*)((const char*)(Kg + (size_t)((kt + 1) * 64 + i * RPI) * kstride) + kvo); rv[i] = *(const u32x4*)((const char*)(Vg + (size_t)((kt + 1) * 64 + i * RPI) * vstride) + vvo); }
        }
        f32x16 x[2];
#pragma unroll
        for (int mt = 0; mt < 2; ++mt) {
            bf16x8 kf[NKS];
#pragma unroll
            for (int ks = 0; ks < NKS; ++ks) kf[ks] = *(const bf16x8*)(kbase + mt * 32 * KROW + ks * 32);
            x[mt] = zero16();
#pragma unroll
            for (int ks = 0; ks < NKS; ++ks) x[mt] = MFMA32(kf[ks], qf[ks], x[mt]);
        }
        bf16x8 av[2][4];
#pragma unroll
        for (int f = 0; f < 4; ++f) { const int kb = 32 * (f >> 1) + 16 * (f & 1); av[0][f] = tr_pair(vbase + kb * VROW, vbase + (kb + 8) * VROW); }
        float mx = x[0][0];
#pragma unroll
        for (int mt = 0; mt < 2; ++mt)
#pragma unroll
            for (int i = 0; i < 16; ++i) mx = fmaxf(mx, x[mt][i]);
        mx = fmaxf(mx, shxf(mx, 32));
        const float mnew = fmaxf(m_run, mx);
        const float alpha = __builtin_amdgcn_exp2f(m_run - mnew);
        m_run = mnew;
        float psum = 0.f;
#pragma unroll
        for (int mt = 0; mt < 2; ++mt)
#pragma unroll
            for (int i = 0; i < 16; ++i) { x[mt][i] = __builtin_amdgcn_exp2f(x[mt][i] - mnew); psum += x[mt][i]; }
        l_run = l_run * alpha + psum;
#pragma unroll
        for (int dt = 0; dt < 4; ++dt) o[dt] = o[dt] * alpha;
        bf16x8 pb[2][2];
#pragma unroll
        for (int mt = 0; mt < 2; ++mt)
#pragma unroll
            for (int s = 0; s < 2; ++s) {
                u32x4 w;
                w.x = pk2(x[mt][8 * s + 0], x[mt][8 * s + 1]); w.y = pk2(x[mt][8 * s + 2], x[mt][8 * s + 3]);
                w.z = pk2(x[mt][8 * s + 4], x[mt][8 * s + 5]); w.w = pk2(x[mt][8 * s + 6], x[mt][8 * s + 7]);
                pb[mt][s] = __builtin_bit_cast(bf16x8, w);
            }
#pragma unroll
        for (int dt = 0; dt < 4; ++dt) {
            if (dt < 3) {
#pragma unroll
                for (int f = 0; f < 4; ++f) { const int kb = 32 * (f >> 1) + 16 * (f & 1); av[(dt + 1) & 1][f] = tr_pair(vbase + kb * VROW + (dt + 1) * 64, vbase + (kb + 8) * VROW + (dt + 1) * 64); }
            }
#pragma unroll
            for (int f = 0; f < 4; ++f) o[dt] = MFMA32(av[dt & 1][f], pb[f >> 1][f & 1], o[dt]);
        }
    }
}

DI void diff_item(const Params& p, unsigned char* smem, float lam, bool samp, int b, int hh, int c) {
    unsigned char* ws = p.ws;
    const bf16_t* P = (const bf16_t*)(ws + WS_P);
    const int tid = opaque_tid(), lane = tid & 63, wave = tid >> 6, r = lane & 31, h = lane >> 5;
    const int comp = wave >> 1, half = wave & 1;
    const int row0 = samp ? NP + b * 64 : b * 2048 + c * 64;
    const bf16_t* Qw = P + (size_t)(row0 + 32 * half) * INW + OFF_Q + hh * 128 + comp * 64;
    const bf16_t *Kg, *Vg; size_t kst; int nkt;
    if (samp) { Kg = (const bf16_t*)(ws + WS_KS) + (size_t)b * 1088 * 1024 + hh * 128; Vg = (const bf16_t*)(ws + WS_VS) + (size_t)b * 1088 * 1024 + hh * 128; kst = 1024; nkt = 17; }
    else { Kg = P + (size_t)b * 2048 * INW + OFF_K + hh * 128; Vg = P + (size_t)b * 2048 * INW + OFF_V + hh * 128; kst = INW; nkt = c + 1; }
    f32x16 o[4]; float m_run, l_run;
    attn_main<64, 128, true>(Qw, INW, Kg, kst, Vg, kst, nkt, comp * 64, 0, smem, o, m_run, l_run);
    const float inv = 1.0f / (l_run + shxf(l_run, 32));
    float* xch = (float*)smem;
    __syncthreads();
    if (comp == 1) {
#pragma unroll
        for (int dt = 0; dt < 4; ++dt)
#pragma unroll
            for (int ig = 0; ig < 4; ++ig) {
                f32x4 w = {o[dt][4 * ig] * inv, o[dt][4 * ig + 1] * inv, o[dt][4 * ig + 2] * inv, o[dt][4 * ig + 3] * inv};
                *(f32x4*)(xch + (32 * half + r) * 132 + 32 * dt + 8 * ig + 4 * h) = w;
            }
    }
    __syncthreads();
    if (comp == 0) {
        float ss = 0.f;
#pragma unroll
        for (int dt = 0; dt < 4; ++dt)
#pragma unroll
            for (int ig = 0; ig < 4; ++ig) {
                const f32x4 w = *(const f32x4*)(xch + (32 * half + r) * 132 + 32 * dt + 8 * ig + 4 * h);
#pragma unroll
                for (int j = 0; j < 4; ++j) { const float v = o[dt][4 * ig + j] * inv - lam * w[j]; o[dt][4 * ig + j] = v; ss += v * v; }
            }
        ss += shxf(ss, 32);
        const float rstd = rsqrtf(ss * (1.0f / 128.0f) + EPS) * 0.8f;
        bf16_t* mo = (bf16_t*)(ws + WS_MIXIN) + (size_t)(row0 + 32 * half + r) * D + hh * 128;
        const float* og = p.in[I_OUTG];
        f32x4 gq[4][4];
#pragma unroll
        for (int dt = 0; dt < 4; ++dt)
#pragma unroll
            for (int ig = 0; ig < 4; ++ig) gq[dt][ig] = *(const f32x4*)(og + 32 * dt + 8 * ig + 4 * h);
#pragma unroll
        for (int dt = 0; dt < 4; ++dt)
#pragma unroll
            for (int ig = 0; ig < 4; ++ig) {
                const int d0 = 32 * dt + 8 * ig + 4 * h;
                const f32x4 g = gq[dt][ig];
                u32x2 w; w.x = pk2(o[dt][4 * ig] * rstd * g[0], o[dt][4 * ig + 1] * rstd * g[1]); w.y = pk2(o[dt][4 * ig + 2] * rstd * g[2], o[dt][4 * ig + 3] * rstd * g[3]);
                *(u32x2*)(mo + d0) = w;
            }
    }
}

DI void mem_item(const Params& p, unsigned char* smem, int rt, int hp) {
    unsigned char* ws = p.ws;
    const bf16_t* P = (const bf16_t*)(ws + WS_P);
    const int tid = opaque_tid(), lane = tid & 63, wave = tid >> 6, r = lane & 31, h = lane >> 5;
    const int head = 2 * hp + (wave >> 1), half = wave & 1;
    const int row0 = rt * 64;
    const bf16_t *Kg, *Vg;
    if (rt < 128) { const int b = rt >> 5; Kg = (const bf16_t*)(ws + WS_MEMKB) + (size_t)b * 256 * 512 + hp * 256; Vg = (const bf16_t*)(ws + WS_MEMVB) + (size_t)b * 256 * 512 + hp * 256; }
    else { const int b = rt - 128; Kg = (const bf16_t*)(ws + WS_CMK) + (size_t)b * 256 * 512 + hp * 256; Vg = (const bf16_t*)(ws + WS_CMV) + (size_t)b * 256 * 512 + hp * 256; }
    const bf16_t* Qw = P + (size_t)(row0 + 32 * half) * INW + OFF_QM + head * 128;
    f32x16 o[4]; float m_run, l_run;
    attn_main<128, 256, false>(Qw, INW, Kg, 512, Vg, 512, 4, (wave >> 1) * 128, (wave >> 1) * 128, smem, o, m_run, l_run);
    const float inv = 1.0f / (l_run + shxf(l_run, 32));
    bf16_t* mo = (bf16_t*)(ws + WS_MIXIN) + (size_t)(row0 + 32 * half + r) * D + 1536 + head * 128;
#pragma unroll
    for (int dt = 0; dt < 4; ++dt)
#pragma unroll
        for (int ig = 0; ig < 4; ++ig) {
            const int d0 = 32 * dt + 8 * ig + 4 * h;
            u32x2 w; w.x = pk2(o[dt][4 * ig] * inv, o[dt][4 * ig + 1] * inv); w.y = pk2(o[dt][4 * ig + 2] * inv, o[dt][4 * ig + 3] * inv);
            *(u32x2*)(mo + d0) = w;
        }
}

DI void mlp_item(const Params& p, unsigned char* smem, int idx) {
    unsigned char* ws = p.ws;
    const bf16_t* P = (const bf16_t*)(ws + WS_P);
    const int tid = opaque_tid(), lane = tid & 63, wave = tid >> 6, r = lane & 31, h = lane >> 5;
    int row0, L, g;
    if (idx < 256) { const int b = idx >> 6, ch = (idx >> 2) & 15; g = idx & 3; row0 = b * 2048 + ch * 128; L = 128; }
    else { const int j = idx - 256; g = j & 3; row0 = NP + (j >> 2) * 64; L = 64; }
    constexpr int VROW = 288;
    __syncthreads();
    for (int c = tid; c < L * 16; c += 256) {
        const int s = c >> 4, cc = c & 15;
        *(u32x4*)(smem + s * VROW + cc * 16) = *(const u32x4*)(P + (size_t)(row0 + s) * INW + OFF_VC + g * 128 + cc * 8);
    }
    __syncthreads();
    if (32 * wave < L) {
        const int t = 32 * wave + r;
        const float* wsrow = p.in[I_CMWS] + ((size_t)g * 128 + t) * 128;
        f32x16 acc[4];
#pragma unroll
        for (int mt = 0; mt < 4; ++mt) acc[mt] = zero16();
        const int gi = lane >> 4, i16 = lane & 15, tq = i16 >> 2, tp = i16 & 3;
        const unsigned char* vbase = smem + (4 * h + tq) * VROW + (16 * (gi & 1)) * 2 + 8 * tp;
        const int nks = 2 * wave + 2;
        f32x4 wa[8], wb[8];
#pragma unroll
        for (int ks = 0; ks < 8; ++ks)
            if (ks < nks) { const int s0 = 16 * ks + 4 * h; wa[ks] = *(const f32x4*)(wsrow + s0); wb[ks] = *(const f32x4*)(wsrow + s0 + 8); }
#pragma unroll
        for (int ks = 0; ks < 8; ++ks)
            if (ks < nks) {
                const int s0 = 16 * ks + 4 * h;
                f32x4 w0 = wa[ks], w1 = wb[ks];
#pragma unroll
                for (int j = 0; j < 4; ++j) { if (s0 + j > t) w0[j] = 0.f; if (s0 + 8 + j > t) w1[j] = 0.f; }
                u32x4 bw; bw.x = pk2(w0[0], w0[1]); bw.y = pk2(w0[2], w0[3]); bw.z = pk2(w1[0], w1[1]); bw.w = pk2(w1[2], w1[3]);
                const bf16x8 bfrag = __builtin_bit_cast(bf16x8, bw);
#pragma unroll
                for (int mt = 0; mt < 4; ++mt) {
                    const bf16x8 a = tr_pair(vbase + (16 * ks) * VROW + mt * 64, vbase + (16 * ks + 8) * VROW + mt * 64);
                    acc[mt] = MFMA32(a, bfrag, acc[mt]);
                }
            }
        const float bias = p.in[I_CMBS][g * 128 + t];
        const bf16_t* up = P + (size_t)(row0 + t) * INW + OFF_U + g * 128;
        bf16_t* mo = (bf16_t*)(ws + WS_MIXIN) + (size_t)(row0 + t) * D + 1024 + g * 128;
        u32x2 uv[4][4];
#pragma unroll
        for (int mt = 0; mt < 4; ++mt)
#pragma unroll
            for (int ig = 0; ig < 4; ++ig) uv[mt][ig] = *(const u32x2*)(up + 32 * mt + 8 * ig + 4 * h);
#pragma unroll
        for (int mt = 0; mt < 4; ++mt)
#pragma unroll
            for (int ig = 0; ig < 4; ++ig) {
                const int c0 = 32 * mt + 8 * ig + 4 * h;
                const u32x2 u = uv[mt][ig];
                u32x2 w;
                w.x = pk2(bflo(u.x) * (acc[mt][4 * ig] + bias), bfhi(u.x) * (acc[mt][4 * ig + 1] + bias));
                w.y = pk2(bflo(u.y) * (acc[mt][4 * ig + 2] + bias), bfhi(u.y) * (acc[mt][4 * ig + 3] + bias));
                *(u32x2*)(mo + c0) = w;
            }
    }
}

DI void phase3(const Params& p, unsigned char* smem) {
    __shared__ int4 s_p3;
    int& s_item = s_p3.x;
    float& s_lam = *(float*)&s_p3.y;
    const int tid = threadIdx.x;
    if (tid < 64) {
        float a = p.in[I_LQ1][tid] * p.in[I_LK1][tid], b = p.in[I_LQ2][tid] * p.in[I_LK2][tid];
        a = wave_sum(a); b = wave_sum(b);
        if (tid == 0) s_lam = expf(a) - expf(b) + 0.2f;
    }
    __syncthreads();
    const float lam = s_lam;
    unsigned* ctr = (unsigned*)(p.ws + WS_CTL);
    constexpr int N_ATT = 1648, N_CONV = 1024, N_ITEMS = N_ATT + N_CONV;
    for (;;) {
        __syncthreads();
        if (tid == 0) s_item = (int)atomicAdd(ctr, 1u);
        __syncthreads();
        const int id = __builtin_amdgcn_readfirstlane(s_item);
        if (id >= N_ITEMS) break;
        int it;
        if (id < 2 * N_CONV) {
            if ((id & 1) == 0) {
                const int cj = (id >> 1) * 8;
#pragma unroll 1
                for (int q = 0; q < 8; ++q) {
                    const int j = cj + q;
                    if (j < 4096) convert_i4_rows(p.in[I_PU], p.ws + WS_UB, (float*)(p.ws + WS_USC), j);
                    else convert4_rows(p.in[I_PV], p.ws + WS_VB, (float*)(p.ws + WS_VSC), j - 4096);
                }
                continue;
            }
            it = id >> 1;
        } else it = id - N_CONV;
        if (it < 480) { diff_item(p, smem, lam, false, (it & 31) >> 3, it & 7, 31 - (it >> 5)); }
        else if (it < 544) { const int j = it - 480; diff_item(p, smem, lam, true, j >> 3, j & 7, 0); }
        else if (it < 832) { const int j = it - 544; diff_item(p, smem, lam, false, (j & 31) >> 3, j & 7, 16 - (j >> 5)); }
        else if (it < 1104) { const int j = it - 832; mem_item(p, smem, j >> 1, j & 1); }
        else if (it < 1392) { mlp_item(p, smem, it - 1104); }
        else { const int j = it - 1392; diff_item(p, smem, lam, false, (j & 31) >> 3, j & 7, 7 - (j >> 5)); }
    }
}

template <int MI> struct RingDepth { static constexpr int v = MI == 4 ? 3 : 4; };
template <int MI> DI void p4_tile(const Params& p, unsigned char* smem, int row0, int tn) {
    unsigned char* ws = p.ws;
    const bf16_t* mixin = (const bf16_t*)(ws + WS_MIXIN);
    const bf16_t* WbT = (const bf16_t*)(ws + WS_WBT);
    const bf16_t* P = (const bf16_t*)(ws + WS_P);
    bf16_t* merged = (bf16_t*)(ws + WS_MERGED);
    f32x16 tot[MI][2];
#pragma unroll
    for (int mi = 0; mi < MI; ++mi) tot[mi][0] = tot[mi][1] = zero16();
    const float* bgp = p.in[I_BGATE] + tn * 128;
    constexpr int GROW = 272;
#pragma unroll 1
    for (int seg = 0; seg < 3; ++seg) {
        const int k0 = seg == 0 ? 0 : (seg == 1 ? 1024 : 1536), nk = seg == 0 ? 32 : 16;
        f32x16 acc[MI][2];
#pragma unroll
        for (int mi = 0; mi < MI; ++mi) acc[mi][0] = acc[mi][1] = zero16();
        gemm_kloop<MI, RingDepth<MI>::v>(acc, mixin + (size_t)row0 * D + k0, D, WbT + (size_t)tn * 128 * D + k0, D, nk, smem);
        {
            const int tid = opaque_tid();
            const bf16_t* gsrc = P + (size_t)row0 * INW + OFF_G + seg * 2048 + tn * 128;
            u32x4 gv[MI * 4];
#pragma unroll
            for (int i = 0; i < MI * 4; ++i) { const int c = tid + 256 * i; gv[i] = *(const u32x4*)(gsrc + (c >> 4) * INW + (c & 15) * 8); }
#pragma unroll
            for (int i = 0; i < MI * 4; ++i) { const int c = tid + 256 * i; *(u32x4*)(smem + (c >> 4) * GROW + (c & 15) * 16) = gv[i]; }
        }
        __syncthreads();
        const float* bseg = bgp + seg * 2048;
        EPI_FOR(MI, acc, {
            const float gl = bf2f(*(const bf16_t*)(smem + row * GROW + col * 2)) + bseg[col];
            const float gate = __builtin_amdgcn_rcpf(1.0f + __builtin_amdgcn_exp2f(gl * -LOG2E));
            tot[mi_][ni_][i_] += gate * v;
        })
        __syncthreads();
    }
    bf16_t* o = merged + (size_t)row0 * D + tn * 128;
    EPI_FOR(MI, tot, { o[row * D + col] = f2bf(v); })
}
DI void phase4(const Params& p, unsigned char* smem) {
    for_tiles(64, 16, [&](int tm, int tn) { p4_tile<2>(p, smem, tm * 128, tn); });
    for_tiles(8, 16, [&](int tm, int tn) { p4_tile<1>(p, smem, NP + tm * 64, tn); });
}

template <int MI> DI void p5_tile(const Params& p, unsigned char* smem, int row0, int tn) {
    unsigned char* ws = p.ws;
    const bf16_t* merged = (const bf16_t*)(ws + WS_MERGED);
    const bf16_t* WoT = (const bf16_t*)(ws + WS_WOT);
    bf16_t* x1g = (bf16_t*)(ws + WS_X1G);
    f32x16 acc[MI][2];
#pragma unroll
    for (int mi = 0; mi < MI; ++mi) acc[mi][0] = acc[mi][1] = zero16();
    gemm_kloop<MI, RingDepth<MI>::v>(acc, merged + (size_t)row0 * D, D, WoT + (size_t)tn * 128 * D, D, 64, smem);
    const float* xin = (row0 < NP ? p.in[I_XP] + (size_t)row0 * D : p.in[I_XS] + (size_t)(row0 - NP) * D) + tn * 128;
    float* y = p.out + O_Y + (size_t)row0 * D + tn * 128;
    bf16_t* xg = x1g + (size_t)row0 * D + tn * 128;
    const float* gfp = p.in[I_NFFNG] + tn * 128;
    {
        const int tid_ = opaque_tid(), lane_ = tid_ & 63, wave_ = tid_ >> 6, r_ = lane_ & 31, h_ = lane_ >> 5;
#pragma unroll
        for (int mi = 0; mi < MI; ++mi)
#pragma unroll
            for (int ni = 0; ni < 2; ++ni) {
                const int col = (wave_ & 1) * 64 + ni * 32 + r_;
                const float gcol = gfp[col];
                float xv[16];
#pragma unroll
                for (int i = 0; i < 16; ++i) xv[i] = xin[((wave_ >> 1) * 32 * MI + mi * 32 + crow(i, h_)) * D + col];
#pragma unroll
                for (int i = 0; i < 16; ++i) {
                    const int row = (wave_ >> 1) * 32 * MI + mi * 32 + crow(i, h_);
                    const float x1 = xv[i] + acc[mi][ni][i];
                    y[row * D + col] = x1;
                    xg[row * D + col] = f2bf(x1 * gcol);
                }
                asm volatile("" ::: "memory");
            }
    }
}
DI void phase5(const Params& p, unsigned char* smem) {
    for_tiles(32, 16, [&](int tm, int tn) { p5_tile<4>(p, smem, tm * 256, tn); });
    for_tiles(8, 16, [&](int tm, int tn) { p5_tile<1>(p, smem, NP + tm * 64, tn); });
}

DI void phase6(const Params& p, unsigned char* smem) {
    unsigned char* ws = p.ws;
    const bf16_t* x1g = (const bf16_t*)(ws + WS_X1G);
    const bf16_t* WqT = (const bf16_t*)(ws + WS_WQT);
    const bf16_t* SK = (const bf16_t*)(ws + WS_SKB);
    float* sc = (float*)(ws + WS_SCORES);
    constexpr int STAGE = 16384, A_BYTES = 8192;
    for_tiles(68, 16, [&](int tm, int tn) {
        f32x16 acc[2][2];
        acc[0][0] = acc[0][1] = acc[1][0] = acc[1][1] = zero16();
        gemm_kloop<2, 4>(acc, x1g + (size_t)tm * 128 * D, D, WqT + (size_t)tn * 128 * D, D, 64, smem);
        const int tid = opaque_tid(), lane = tid & 63, wave = tid >> 6, wm = wave >> 1, wn = wave & 1, r = lane & 31, h = lane >> 5;
        {
            const int frow = lane >> 2, fslot = lane & 3;
            const bf16_t* Bg = SK + (size_t)tn * 128 * 128;
#pragma unroll
            for (int sl = 0; sl < 4; ++sl)
#pragma unroll
                for (int i = 0; i < 2; ++i) {
                    const int R = (wave * 2 + i) * 16 + frow;
                    __builtin_amdgcn_global_load_lds((GLB1 const void*)(Bg + R * 128 + (fslot ^ ((R >> 2) & 3)) * 8 + sl * 32), (LDS3 void*)(smem + sl * STAGE + A_BYTES + (wave * 2 + i) * 1024), 16, 0, 0);
                }
        }
#pragma unroll
        for (int mi = 0; mi < 2; ++mi)
#pragma unroll
            for (int ni = 0; ni < 2; ++ni)
#pragma unroll
                for (int i = 0; i < 16; ++i) {
                    const int row = wm * 64 + mi * 32 + crow(i, h), k = wn * 64 + ni * 32 + r;
                    *(bf16_t*)(smem + (k >> 5) * STAGE + row * 64 + ((((k & 31) >> 3) ^ ((row >> 2) & 3)) * 16) + (k & 7) * 2) = f2bf(acc[mi][ni][i]);
                }
        asm volatile("s_waitcnt vmcnt(0)" ::: "memory");
        __syncthreads();
        f32x16 acc2[2][2];
        acc2[0][0] = acc2[0][1] = acc2[1][0] = acc2[1][1] = zero16();
        {
            const int sw = (r >> 2) & 3;
            const int a_rd = (wm * 64 + r) * 64, b_rd = A_BYTES + (wn * 64 + r) * 64;
#pragma unroll
            for (int sl = 0; sl < 4; ++sl)
#pragma unroll
                for (int ks = 0; ks < 2; ++ks) {
                    const unsigned char* st = smem + sl * STAGE;
                    const int ko = ((2 * ks + h) ^ sw) * 16;
                    const bf16x8 a0 = *(const bf16x8*)(st + a_rd + ko), a1 = *(const bf16x8*)(st + a_rd + 32 * 64 + ko);
                    const bf16x8 b0 = *(const bf16x8*)(st + b_rd + ko), b1 = *(const bf16x8*)(st + b_rd + 32 * 64 + ko);
                    acc2[0][0] = MFMA32(a0, b0, acc2[0][0]); acc2[0][1] = MFMA32(a0, b1, acc2[0][1]);
                    acc2[1][0] = MFMA32(a1, b0, acc2[1][0]); acc2[1][1] = MFMA32(a1, b1, acc2[1][1]);
                }
        }
        __syncthreads();
        float* o = sc + (size_t)tm * 128 * D + tn * 128;
        EPI_FOR(2, acc2, { o[row * D + col] = v; })
    });
}
DI void phase7(const Params& p, unsigned char* smem) {}

DI float dot2u(unsigned a, unsigned b, float acc) { return __builtin_amdgcn_fdot2_f32_bf16(__builtin_bit_cast(bf16v2, a), __builtin_bit_cast(bf16v2, b), acc, false); }
DI float dot8(u32x4 a, u32x4 b, float acc) {
    const unsigned a0 = a.x, a1 = a.y, a2 = a.z, a3 = a.w, b0 = b.x, b1 = b.y, b2 = b.z, b3 = b.w;
    acc = dot2u(a0, b0, acc); acc = dot2u(a1, b1, acc); acc = dot2u(a2, b2, acc); acc = dot2u(a3, b3, acc);
    return acc;
}
DI float rdl(float v, int i) { return __int_as_float(__builtin_amdgcn_readlane(__float_as_int(v), i)); }
DI int f2key(float f) { const int k = __float_as_int(f); return k ^ ((k >> 31) & 0x7fffffff); }
DI int imax(int a, int b) { return a > b ? a : b; }
DI int imin(int a, int b) { return a < b ? a : b; }
DI void bitonic128(int& a, int& b, int lane) {
#pragma unroll
    for (int k = 2; k <= 128; k <<= 1) {
#pragma unroll
        for (int j = k >> 1; j > 0; j >>= 1) {
            if (j == 64) { const int na = imax(a, b), nb = imin(a, b); a = na; b = nb; }
            else {
                const int pa = shx(a, j), pb = shx(b, j);
                const bool lowj = (lane & j) == 0;
                bool kma, kmb;
                if (k < 64) { kma = ((lane & k) == 0) == lowj; kmb = kma; }
                else if (k == 64) { kma = lowj; kmb = !lowj; }
                else { kma = lowj; kmb = lowj; }
                a = kma ? imax(a, pa) : imin(a, pa);
                b = kmb ? imax(b, pb) : imin(b, pb);
            }
        }
    }
}
DI void bitonic64(int& a, int lane) {
#pragma unroll
    for (int k = 2; k <= 64; k <<= 1) {
#pragma unroll
        for (int j = k >> 1; j > 0; j >>= 1) {
            const int pa = shx(a, j);
            const bool lowj = (lane & j) == 0;
            const bool km = (k < 64) ? (((lane & k) == 0) == lowj) : lowj;
            a = km ? imax(a, pa) : imin(a, pa);
        }
    }
}
DI void phase8(const Params& p, unsigned char* smem) {
    unsigned char* ws = p.ws;
    const int tid = threadIdx.x, lane = tid & 63, wave = tid >> 6;
    const bf16_t* x1g = (const bf16_t*)(ws + WS_X1G);
    const float* scores = (const float*)(ws + WS_SCORES);
    const unsigned char* Ub = ws + WS_UB;
    const float* usc = (const float*)(ws + WS_USC);
    const unsigned char* Vb = ws + WS_VB;
    const float* vsc = (const float*)(ws + WS_VSC);
    int ca = 0, cb = lane, cvalid = 0;
#pragma unroll
    for (int aa = 0; aa < 16; ++aa) { const int cnt = 16 / (aa + 1); if (!cvalid) { if (cb < cnt) { ca = aa; cvalid = 1; } else cb -= cnt; } }
    if (!cvalid) { ca = 0; cb = 0; }

    int* wge = (int*)(smem + wave * 1024);
    float* wgg = (float*)(smem + wave * 1024 + 512);
    for (int t = blockIdx.x * 4 + wave; t < MT; t += gridDim.x * 4) {
        float* yrow = p.out + O_Y + (size_t)t * D;
        float ss = 0.f;
#pragma unroll
        for (int c = 0; c < 2; ++c)
#pragma unroll
            for (int q = 0; q < 4; ++q) { const f32x4 xv = *(const f32x4*)(yrow + c * 1024 + lane * 16 + 4 * q); ss += xv[0] * xv[0] + xv[1] * xv[1] + xv[2] * xv[2] + xv[3] * xv[3]; }
        const float rstd = rsqrtf(wave_sum(ss) * (1.0f / 2048.0f) + EPS);
        unsigned hq1[2][2], hq2[2][2];
        float hs1, hs2;
        {
            float hf[2][16];
            float am = 0.f;
#pragma unroll
            for (int c = 0; c < 2; ++c) {
                const u32x4 h0 = *(const u32x4*)(x1g + (size_t)t * D + c * 1024 + lane * 16), h1 = *(const u32x4*)(x1g + (size_t)t * D + c * 1024 + lane * 16 + 8);
                unpack8(h0, &hf[c][0]); unpack8(h1, &hf[c][8]);
#pragma unroll
                for (int j = 0; j < 16; ++j) am = fmaxf(am, fabsf(hf[c][j]));
            }
#pragma unroll
            for (int o = 32; o > 0; o >>= 1) am = fmaxf(am, shxf(am, o));
            hs1 = am > 0.f ? am * (1.0f / 7.0f) : 1.0f; hs2 = hs1 * (1.0f / 14.0f);
            const float i1 = 1.0f / hs1, i2 = 1.0f / hs2;
#pragma unroll
            for (int c = 0; c < 2; ++c)
#pragma unroll
                for (int d = 0; d < 2; ++d) {
                    unsigned a = 0, b = 0;
#pragma unroll
                    for (int j = 0; j < 8; ++j) {
                        const float x = hf[c][8 * d + j];
                        const float q1 = fminf(fmaxf(rintf(x * i1), -7.0f), 7.0f);
                        const float q2 = fminf(fmaxf(rintf((x - q1 * hs1) * i2), -7.0f), 7.0f);
                        a |= ((unsigned)(int)q1 & 0xFu) << (4 * j); b |= ((unsigned)(int)q2 & 0xFu) << (4 * j);
                    }
                    hq1[c][d] = a; hq2[c][d] = b;
                }
        }
#pragma unroll 1
        for (int hp = 0; hp < 4; ++hp) {
#pragma unroll
            for (int hh = 0; hh < 2; ++hh) {
                const float* sc = scores + (size_t)t * D + (hp * 2 + hh) * 256;
                const float v0a = sc[lane], v0b = sc[64 + lane], v1a = sc[128 + lane], v1b = sc[192 + lane];
                int k0a = (f2key(v0a) & ~127) | (127 - lane), k0b = (f2key(v0b) & ~127) | (63 - lane);
                int k1a = (f2key(v1a) & ~127) | (127 - lane), k1b = (f2key(v1b) & ~127) | (63 - lane);
                bitonic128(k0a, k0b, lane);
                bitonic128(k1a, k1b, lane);
                const int i0 = 127 - (k0a & 127), i1 = 127 - (k1a & 127);
                const float s0a = __shfl(v0a, i0 & 63), s0b = __shfl(v0b, i0 & 63), s1a = __shfl(v1a, i1 & 63), s1b = __shfl(v1b, i1 & 63);
                const float s0 = (i0 & 64) ? s0b : s0a, s1 = (i1 & 64) ? s1b : s1a;
                const float cval = __shfl(s0, ca) + __shfl(s1, cb);
                const int cexp = __shfl(i0, ca) * 128 + __shfl(i1, cb);
                int ck = cvalid ? ((f2key(cval) & ~63) | (63 - lane)) : (int)0x80000000;
                bitonic64(ck, lane);
                const int src = 63 - (ck & 63);
                const float tv = __shfl(cval, src);
                const int te = __shfl(cexp, src);
                const float mx = rdl(tv, 0);
                const float ew = lane < 16 ? __expf(rstd * (tv - mx)) : 0.f;
                float sum = ew;
                sum += shxf(sum, 8); sum += shxf(sum, 4); sum += shxf(sum, 2); sum += shxf(sum, 1);
                if (lane < 16) { wge[(hp * 2 + hh) * 16 + lane] = te; wgg[(hp * 2 + hh) * 16 + lane] = ew / sum; }
            }
        }
        f32x2 oacc2[2][8];
#pragma unroll
        for (int c = 0; c < 2; ++c)
#pragma unroll
            for (int j = 0; j < 8; ++j) oacc2[c][j] = (f32x2){0.f, 0.f};
#define PEER_LOAD(e_, ex_, gx_, us_, uu_, vv_)                                                                                   \
        {                                                                                                                   \
            _Pragma("unroll") for (int k = 0; k < 4; ++k) { ex_[k] = __builtin_amdgcn_readfirstlane(wge[(e_) + k]); gx_[k] = wgg[(e_) + k]; } \
            _Pragma("unroll") for (int k = 0; k < 4; ++k) { gx_[k] *= vsc[ex_[k]]; us_[k] = usc[ex_[k]]; }                \
            _Pragma("unroll") for (int k = 0; k < 4; ++k) _Pragma("unroll") for (int c = 0; c < 2; ++c)                     \
                uu_[k][c] = *(const u32x2*)(Ub + (size_t)ex_[k] * 1024 + c * 512 + lane * 8);                                \
            _Pragma("unroll") for (int k = 0; k < 4; ++k) _Pragma("unroll") for (int c = 0; c < 2; ++c)                     \
                vv_[k][c] = *(const u32x2*)(Vb + (size_t)ex_[k] * 1024 + c * 512 + lane * 8);                                \
        }
#define PEER_COMPUTE(ex_, gx_, us_, uu_, vv_)                                                                                    \
        {                                                                                                                   \
            float dd[4];                                                                                                    \
            _Pragma("unroll") for (int k = 0; k < 4; ++k) {                                                                 \
                int i1 = 0, i2 = 0;                                                                                         \
                _Pragma("unroll") for (int c = 0; c < 2; ++c) _Pragma("unroll") for (int q = 0; q < 2; ++q) {               \
                    const int w = (int)uu_[k][c][q];                                                                        \
                    i1 = __builtin_amdgcn_sdot8(w, (int)hq1[c][q], i1, false); i2 = __builtin_amdgcn_sdot8(w, (int)hq2[c][q], i2, false); \
                }                                                                                                           \
                dd[k] = (hs1 * (float)i1 + hs2 * (float)i2) * us_[k];                                                       \
                __builtin_amdgcn_sched_barrier(0);                    \
            }                                                                                                               \
            _Pragma("unroll") for (int o = 32; o > 0; o >>= 1) { _Pragma("unroll") for (int k = 0; k < 4; ++k) dd[k] += shxf(dd[k], o); } \
            _Pragma("unroll") for (int k = 0; k < 4; ++k) {                                                                 \
                const float aa = gx_[k] * gelu_fast(dd[k] * rstd);                                                   \
                const f32x2 ab = {aa, aa};                                                                                  \
                _Pragma("unroll") for (int c = 0; c < 2; ++c) _Pragma("unroll") for (int q = 0; q < 2; ++q) {               \
                    const unsigned w = vv_[k][c][q];                                                                        \
                    const f32x2 e0 = __builtin_amdgcn_cvt_scalef32_pk_f32_fp4(w, 1.0f, 0), e1 = __builtin_amdgcn_cvt_scalef32_pk_f32_fp4(w, 1.0f, 1); \
                    const f32x2 e2 = __builtin_amdgcn_cvt_scalef32_pk_f32_fp4(w, 1.0f, 2), e3 = __builtin_amdgcn_cvt_scalef32_pk_f32_fp4(w, 1.0f, 3); \
                    oacc2[c][4 * q] = ab * e0 + oacc2[c][4 * q]; oacc2[c][4 * q + 1] = ab * e1 + oacc2[c][4 * q + 1];       \
                    oacc2[c][4 * q + 2] = ab * e2 + oacc2[c][4 * q + 2]; oacc2[c][4 * q + 3] = ab * e3 + oacc2[c][4 * q + 3]; \
                }                                                                                                           \
                __builtin_amdgcn_sched_barrier(0);                                                                          \
            }                                                                                                               \
        }
        {
            int exA[4], exB[4]; float gxA[4], gxB[4], usA[4], usB[4];
            u32x2 uuA[4][2], uuB[4][2], vvA[4][2], vvB[4][2];
            PEER_LOAD(0, exA, gxA, usA, uuA, vvA)
#pragma unroll 1
            for (int e = 0; e < 128; e += 8) {
                PEER_LOAD(e + 4, exB, gxB, usB, uuB, vvB)
                PEER_COMPUTE(exA, gxA, usA, uuA, vvA)
                if (e + 8 < 128) PEER_LOAD(e + 8, exA, gxA, usA, uuA, vvA)
                PEER_COMPUTE(exB, gxB, usB, uuB, vvB)
            }
        }
#undef PEER_LOAD
#undef PEER_COMPUTE
        f32x4 xr[2][4];
#pragma unroll
        for (int c = 0; c < 2; ++c)
#pragma unroll
            for (int q = 0; q < 4; ++q) xr[c][q] = *(const f32x4*)(yrow + c * 1024 + lane * 16 + 4 * q);
#pragma unroll
        for (int c = 0; c < 2; ++c)
#pragma unroll
            for (int q = 0; q < 4; ++q) {
                f32x4 xv = xr[c][q];
                xv[0] += oacc2[c][2 * q][0]; xv[1] += oacc2[c][2 * q][1]; xv[2] += oacc2[c][2 * q + 1][0]; xv[3] += oacc2[c][2 * q + 1][1];
                *(f32x4*)(yrow + c * 1024 + lane * 16 + 4 * q) = xv;
            }
    }
}

#define XB_TMO      128
#define XB_XCNT(j)  (256  + 64 * (j))
#define XB_XSUB(j)  (1280 + 64 * (j))
#define XB_XGEN(j)  (2304 + 64 * (j))
#define XB_TOP      3328
#define XB_TOPGEN   3392
#define XCD_BAR_WORDS 3456
#define XB_SPIN_CAP (1u << 18)
DI unsigned xb_ld(unsigned* p) { return __hip_atomic_load(p, __ATOMIC_RELAXED, __HIP_MEMORY_SCOPE_AGENT); }
DI unsigned xb_add(unsigned* p, unsigned v) { return __hip_atomic_fetch_add(p, v, __ATOMIC_RELAXED, __HIP_MEMORY_SCOPE_AGENT); }
DI unsigned xb_xcc_id() { return (unsigned)__builtin_amdgcn_s_getreg((3 << 11) | 20) & 0xFu; }
#define XB_SPIN(cond, bar) do { unsigned _sp = 0; while (cond) { __builtin_amdgcn_s_sleep(1); \
    if ((++_sp & 255u) == 0u) { if (xb_ld(&(bar)[XB_TMO])) break; if (_sp > XB_SPIN_CAP) { atomicAdd(&(bar)[XB_TMO], 1u); break; } } } } while (0)
struct XcdBarrier { unsigned* bar; unsigned x; volatile LDS3 unsigned* st; };
DI XcdBarrier xcd_barrier_post(unsigned* bar, volatile LDS3 unsigned* st) {
    XcdBarrier b; b.bar = bar; b.x = xb_xcc_id(); b.st = st;
    if (threadIdx.x == 0) (void)xb_add(&bar[XB_XCNT(b.x)], 1u);
    return b;
}
DI void xcd_barrier_complete(unsigned* bar, unsigned x, unsigned& nloc, unsigned& nx) {
    const unsigned G = gridDim.x * gridDim.y * gridDim.z;
    unsigned sum, cnt, mine, sp = 0u;
    for (;;) {
        sum = 0u; cnt = 0u; mine = 0u;
#pragma unroll
        for (unsigned j = 0; j < 16; ++j) { const unsigned c = xb_ld(&bar[XB_XCNT(j)]); sum += c; cnt += (c > 0u) ? 1u : 0u; mine = (j == x) ? c : mine; }
        if (sum == G) break;
        __builtin_amdgcn_s_sleep(1);
        if ((++sp & 255u) == 0u) { if (xb_ld(&bar[XB_TMO])) break; if (sp > XB_SPIN_CAP) { atomicAdd(&bar[XB_TMO], 1u); break; } }
    }
    nloc = mine > 0u ? mine : 1u; nx = cnt > 0u ? cnt : 1u;
}
DI void xcd_barrier(const XcdBarrier& b) {
    asm volatile("s_waitcnt vmcnt(0)" ::: "memory");
    __syncthreads();
    if (threadIdx.x == 0) {
        unsigned* bar = b.bar;
        __builtin_amdgcn_s_waitcnt(0);
        unsigned nloc = b.st[0], nx = b.st[1];
        if (nloc == 0u) { xcd_barrier_complete(bar, b.x, nloc, nx); b.st[0] = nloc; b.st[1] = nx; }
        const unsigned old = xb_add(&bar[XB_XSUB(b.x)], 1u);
        const unsigned gen = old / nloc;
        if (old + 1u == (gen + 1u) * nloc) {
            __builtin_amdgcn_fence(__ATOMIC_RELEASE, "agent");
            asm volatile("s_waitcnt vmcnt(0)" ::: "memory");
            const unsigned og = xb_add(&bar[XB_TOP], 1u);
            const unsigned tg = og / nx;
            if (og + 1u == (tg + 1u) * nx) xb_add(&bar[XB_TOPGEN], 1u);
            else XB_SPIN(xb_ld(&bar[XB_TOPGEN]) == tg, bar);
            __builtin_amdgcn_fence(__ATOMIC_ACQUIRE, "agent");
            xb_add(&bar[XB_XGEN(b.x)], 1u);
            asm volatile("s_waitcnt vmcnt(0)" ::: "memory");
        } else {
            XB_SPIN(xb_ld(&bar[XB_XGEN(b.x)]) == gen, bar);
            __builtin_amdgcn_fence(__ATOMIC_ACQUIRE, "agent");
            asm volatile("s_waitcnt vmcnt(0)" ::: "memory");
        }
    }
    __syncthreads();
}

__global__ void __launch_bounds__(256, 2) mega(Params p, int ph_lo, int ph_hi, int coop) {
    extern __shared__ __attribute__((aligned(16))) unsigned char smem[];
    __shared__ uint4 xb_words;
    if (threadIdx.x == 0) xb_words = make_uint4(0u, 0u, 0u, 0u);
    __syncthreads();
    XcdBarrier xb;
    xb.bar = nullptr; xb.x = 0; xb.st = nullptr;
    if (coop) xb = xcd_barrier_post((unsigned*)(p.ws + WS_BAR), (volatile LDS3 unsigned*)&xb_words);
    if (coop == 2) cg::this_grid().sync();
#define RUN_PHASE(k, fn)                                              \
    if (ph_lo <= (k) && (k) < ph_hi) {                                  \
        fn(p, smem);                                                    \
        if (coop && (k) + 1 < ph_hi) xcd_barrier(xb);                   \
    }
    RUN_PHASE(0, phase0)
    RUN_PHASE(1, phase1)
    RUN_PHASE(2, phase2)
    RUN_PHASE(3, phase3)
    RUN_PHASE(4, phase4)
    RUN_PHASE(5, phase5)
    RUN_PHASE(6, phase6)
    RUN_PHASE(8, phase8)
}

#ifndef N_LAUNCH_MODE
#define N_LAUNCH_MODE 1
#endif

extern "C" void kernel_launch(void* const* d_in, const int* in_sizes, int n_in, void* d_out, int out_size, void* d_ws, size_t ws_size, hipStream_t stream) {
    static int grid = 0;
    if (grid == 0) {
        int dev = 0, cus = 0, per_cu = 0;
        hipGetDevice(&dev);
        hipDeviceGetAttribute(&cus, hipDeviceAttributeMultiprocessorCount, dev);
        hipFuncSetAttribute((const void*)mega, hipFuncAttributeMaxDynamicSharedMemorySize, LDS_BYTES);
        hipOccupancyMaxActiveBlocksPerMultiprocessor(&per_cu, (const void*)mega, 256, LDS_BYTES);
        if (per_cu < 1) per_cu = 1;
        if (per_cu > 2) per_cu = 2;
        grid = cus * per_cu;
        if (n_in != 32 || ws_size < WS_END) { fprintf(stderr, "kernel_launch: unexpected n_in %d / ws_size %zu (need %zu)\n", n_in, ws_size, (size_t)WS_END); grid = -1; }
    }
    if (grid < 0) return;
    Params p{};
    for (int i = 0; i < 32; ++i) p.in[i] = (const float*)d_in[i];
    p.out = (float*)d_out;
    p.ws = (unsigned char*)d_ws;
    hipMemsetAsync((char*)d_ws + WS_CTL, 0, 32768, stream);
#if N_LAUNCH_MODE == 1
    int lo = 0, hi = 9, coop = 1;
    void* args[] = {&p, &lo, &hi, &coop};
    hipError_t e = hipLaunchCooperativeKernel((const void*)mega, dim3(grid), dim3(256), args, LDS_BYTES, stream);
    if (e != hipSuccess) fprintf(stderr, "cooperative launch failed: %s (grid %d)\n", hipGetErrorString(e), grid);
#else
    for (int ph = 0; ph < 9; ++ph) hipLaunchKernelGGL(mega, dim3(grid), dim3(256), LDS_BYTES, stream, p, ph, ph + 1, 0);
#endif
}
```

```cpp
#include <hip/hip_runtime.h>
#include <hip/hip_cooperative_groups.h>
#include <cstdint>
#include <cstdio>
namespace cg = cooperative_groups;

#define DI __device__ __forceinline__
typedef unsigned short bf16_t;
typedef short bf16x8 __attribute__((ext_vector_type(8)));
typedef short s16x4 __attribute__((ext_vector_type(4)));
typedef float f32x16 __attribute__((ext_vector_type(16)));
typedef float f32x4 __attribute__((ext_vector_type(4)));
typedef float f32x2 __attribute__((ext_vector_type(2)));
typedef unsigned u32x4 __attribute__((ext_vector_type(4)));
typedef unsigned u32x2 __attribute__((ext_vector_type(2)));
typedef __bf16 bf16v2 __attribute__((ext_vector_type(2)));
#define LDS3 __attribute__((address_space(3)))

constexpr int D = 2048, NP = 8192, NS = 512, MT = 8704, INW = 10752;
constexpr int OFF_Q = 0, OFF_K = 1024, OFF_V = 2048, OFF_U = 3072, OFF_VC = 3584, OFF_QM = 4096, OFF_G = 4608;
constexpr float EPS = 1e-6f;
constexpr float LOG2E = 1.4426950408889634f;
constexpr size_t O_Y = 0, O_KP = 17825792, O_VP = 26214400, O_MKP = 34603008, O_MVP = 35127296, O_KS = 35651584, O_VS = 36175872, O_CVS = 36700160;
constexpr size_t WS_CTL = 0;
constexpr size_t WS_BAR = 4096;
constexpr size_t WS_UB = 32768;
constexpr size_t WS_VB = WS_UB + 67108864;
constexpr size_t WS_P = WS_VB + 67108864;
constexpr size_t WS_WINT = WS_P + 187170816;
constexpr size_t WS_HB = WS_WINT + 44040192;
constexpr size_t WS_WMEMT = WS_HB + 35651584;
constexpr size_t WS_WBT = WS_WMEMT + 4194304;
constexpr size_t WS_WOT = WS_WBT + 8388608;
constexpr size_t WS_WQT = WS_WOT + 8388608;
constexpr size_t WS_MEMHB = WS_WQT + 8388608;
constexpr size_t WS_SKB = WS_MEMHB + 4194304;
constexpr size_t WS_KS = WS_SKB + 524288;
constexpr size_t WS_VS = WS_KS + 17825792;
constexpr size_t WS_MEMKV = WS_VS + 17825792;
constexpr size_t WS_MEMKB = WS_MEMKV + 4194304;
constexpr size_t WS_MEMVB = WS_MEMKB + 1048576;
constexpr size_t WS_CMK = WS_MEMVB + 1048576;
constexpr size_t WS_CMV = WS_CMK + 2097152;
constexpr size_t WS_VSC = WS_CMV + 2097152;
constexpr size_t WS_USC = WS_VSC + 65536;
constexpr size_t WS_ROPE = WS_USC + 65536;
constexpr size_t WS_END = WS_ROPE + 2112 * 8 * 8;
constexpr size_t WS_MIXIN = WS_WINT;
constexpr size_t WS_MERGED = WS_HB;
constexpr size_t WS_X1G = WS_WINT;
constexpr size_t WS_PEERQ = WS_HB;
constexpr size_t WS_SCORES = WS_P;

constexpr int LDS_BYTES = 73728;

struct Params {
    const float* in[32];
    float* out;
    unsigned char* ws;
};
enum { I_XP = 0, I_XS, I_MEMP, I_CDK, I_CDV, I_CMK, I_CMV, I_NMIXG, I_WIN, I_BGATE, I_QNG, I_KNG, I_LQ1, I_LK1, I_LQ2, I_LK2, I_OUTG,
       I_CMLNG, I_CMLNB, I_CMWS, I_CMBS, I_NMEMG, I_WMEMKV, I_MQNG, I_MKNG, I_WBR, I_WOUT, I_NFFNG, I_PWQ, I_PSK, I_PU, I_PV };

DI unsigned pk2(float lo, float hi) { f32x2 f = {lo, hi}; bf16v2 b = __builtin_convertvector(f, bf16v2); return __builtin_bit_cast(unsigned, b); }
DI bf16_t f2bf(float x) { return (bf16_t)(pk2(x, 0.f) & 0xffffu); }
DI float bflo(unsigned u) { return __uint_as_float(u << 16); }
DI float bfhi(unsigned u) { return __uint_as_float(u & 0xffff0000u); }
DI float bf2f(bf16_t b) { return __uint_as_float(((unsigned)b) << 16); }
DI void unpack8(u32x4 v, float* f) { f[0] = bflo(v.x); f[1] = bfhi(v.x); f[2] = bflo(v.y); f[3] = bfhi(v.y); f[4] = bflo(v.z); f[5] = bfhi(v.z); f[6] = bflo(v.w); f[7] = bfhi(v.w); }
DI u32x4 pack8(const float* f) { u32x4 r; r.x = pk2(f[0], f[1]); r.y = pk2(f[2], f[3]); r.z = pk2(f[4], f[5]); r.w = pk2(f[6], f[7]); return r; }
DI int shx(int v, int j) {
    switch (j) {
        case 1: return __builtin_amdgcn_update_dpp(0, v, 0xB1, 0xF, 0xF, true);
        case 2: return __builtin_amdgcn_update_dpp(0, v, 0x4E, 0xF, 0xF, true);
        case 4: return __builtin_amdgcn_update_dpp(0, __builtin_amdgcn_update_dpp(0, v, 0x141, 0xF, 0xF, true), 0x1B, 0xF, 0xF, true);
        case 8: return __builtin_amdgcn_update_dpp(0, v, 0x128, 0xF, 0xF, true);
        case 16: { const u32x2 r = __builtin_amdgcn_permlane16_swap((unsigned)v, (unsigned)v, false, false); return (threadIdx.x & 16) ? (int)r[0] : (int)r[1]; }
        default: { const u32x2 r = __builtin_amdgcn_permlane32_swap((unsigned)v, (unsigned)v, false, false); return (threadIdx.x & 32) ? (int)r[0] : (int)r[1]; }
    }
}
DI float shxf(float v, int j) { return __int_as_float(shx(__float_as_int(v), j)); }
DI float wave_sum(float v) {
#pragma unroll
    for (int o = 32; o > 0; o >>= 1) v += shxf(v, o);
    return v;
}
DI int opaque_tid() { int t = threadIdx.x; asm volatile("" : "+v"(t)); return t; }
DI int crow(int i, int h) { return (i & 3) + 8 * (i >> 2) + 4 * h; }
DI float gelu_exact(float x) { return 0.5f * x * (1.0f + erff(x * 0.70710678118654752f)); }
DI float gelu_fast(float v) {
    const float av = fabsf(v), t = __builtin_amdgcn_rcpf(av * 0.2316418882f + 1.0f);
    float q = t * 0.5307027145f + (-0.7265760135f); q = q * t + 0.7107068705f; q = q * t + (-0.142248368f); q = q * t + 0.127414796f; q = q * t;
    const float e = __builtin_amdgcn_exp2f((v * v) * (-0.72134752044f));
    const float m = v * (q * e);
    return v < 0.f ? m : v - m;
}
#define MFMA32(a, b, c) __builtin_amdgcn_mfma_f32_32x32x16_bf16((a), (b), (c), 0, 0, 0)
DI f32x16 zero16() { f32x16 z; for (int i = 0; i < 16; ++i) z[i] = 0.f; return z; }
DI bf16x8 tr_pair(const unsigned char* lo, const unsigned char* hi) {
    s16x4 a = __builtin_amdgcn_ds_read_tr16_b64_v4i16((LDS3 s16x4*)lo);
    s16x4 b = __builtin_amdgcn_ds_read_tr16_b64_v4i16((LDS3 s16x4*)hi);
    return __builtin_shufflevector(a, b, 0, 1, 2, 3, 4, 5, 6, 7);
}

#define SGPR(x) __builtin_amdgcn_readfirstlane(x)
template <class F> DI void for_tiles(int TM, int TN, F f) {
    const int T = TM * TN, G = gridDim.x, bid = blockIdx.x;
    const int nx = (G % 8 == 0) ? 8 : 1;
    const int xcd = SGPR(bid % nx), idx = SGPR(bid / nx), per = SGPR(G / nx);
    const int chunk = SGPR((T + nx - 1) / nx);
    for (int v = idx; v < chunk; v += per) {
        const int id = xcd * chunk + v;
        if (id >= T) break;
        const int gsize = 8 * TN, g = SGPR(id / gsize), rem = id - g * gsize;
        const int mrows = (TM - 8 * g) < 8 ? (TM - 8 * g) : 8;
        const int tn = SGPR(rem / mrows), tm = 8 * g + (rem - tn * mrows);
        f(tm, tn);
    }
}

#define GLB1 __attribute__((address_space(1)))
template <int N> DI void wait_vm() {
    if constexpr (N == 0) asm volatile("s_waitcnt vmcnt(0)" ::: "memory");
    else if constexpr (N == 3) asm volatile("s_waitcnt vmcnt(3)" ::: "memory");
    else if constexpr (N == 4) asm volatile("s_waitcnt vmcnt(4)" ::: "memory");
    else if constexpr (N == 6) asm volatile("s_waitcnt vmcnt(6)" ::: "memory");
    else if constexpr (N == 8) asm volatile("s_waitcnt vmcnt(8)" ::: "memory");
    else if constexpr (N == 12) asm volatile("s_waitcnt vmcnt(12)" ::: "memory");
    else if constexpr (N == 16) asm volatile("s_waitcnt vmcnt(16)" ::: "memory");
    else static_assert(N == 0, "add the count");
}
template <int MI, int NST>
DI void gemm_kloop(f32x16 (&acc)[MI][2], const bf16_t* __restrict__ Ag, int lda, const bf16_t* __restrict__ Bg, int ldb, int nk  , unsigned char* smem) {
    constexpr int AROWS = 64 * MI, A_BYTES = AROWS * 64, STAGE = A_BYTES + 128 * 64, AL = MI  , BL = 2, LPW = AL + BL;
    static_assert(NST >= 3 && NST * STAGE <= 73728, "ring does not fit");
    const int tid = opaque_tid(), lane = tid & 63, wave = tid >> 6, wm = wave >> 1, wn = wave & 1, r = lane & 31, h = lane >> 5;
    const int frow = lane >> 2, fslot = lane & 3;
    const int kcs = (fslot ^ ((frow >> 2) & 3)) * 8;
    const int aoff0 = (wave * AL * 16 + frow) * lda + kcs, boff0 = (wave * BL * 16 + frow) * ldb + kcs;
    unsigned char* afill = smem + wave * AL * 1024;
    unsigned char* bfill = smem + A_BYTES + wave * BL * 1024;
#define GEMM_FILL(slot_, kt_)                                                                                                        \
    {                                                                                                                                \
        _Pragma("unroll") for (int i = 0; i < AL; ++i)                                                                               \
            __builtin_amdgcn_global_load_lds((GLB1 const void*)(Ag + (size_t)(i * 16) * lda + (kt_) * 32 + aoff0), (LDS3 void*)(afill + (slot_) * STAGE + i * 1024), 16, 0, 0); \
        _Pragma("unroll") for (int i = 0; i < BL; ++i)                                                                               \
            __builtin_amdgcn_global_load_lds((GLB1 const void*)(Bg + (size_t)(i * 16) * ldb + (kt_) * 32 + boff0), (LDS3 void*)(bfill + (slot_) * STAGE + i * 1024), 16, 0, 0); \
    }
#pragma unroll
    for (int t = 0; t < NST - 1; ++t) GEMM_FILL(t, t)
    const int sw = (r >> 2) & 3;
    const int k0off = ((0 + h) ^ sw) * 16, k1off = ((2 + h) ^ sw) * 16;
    const int a_rd = (wm * 32 * MI + r) * 64;
    const int b_rd = A_BYTES + (wn * 64 + r) * 64;
    int slot = 0;
    for (int kt = 0; kt < nk; ++kt) {
        const int rem = nk - 1 - kt;
        if (rem >= NST - 2) wait_vm<(NST - 2) * LPW>();
        else if (NST >= 4 && rem == 2) wait_vm<2 * LPW>();
        else if (rem == 1) wait_vm<LPW>();
        else wait_vm<0>();
        __builtin_amdgcn_s_barrier();
        asm volatile("" ::: "memory");
        if (kt + NST - 1 < nk) { const int fs = slot == 0 ? NST - 1 : slot - 1; GEMM_FILL(fs, kt + NST - 1) }
        const unsigned char* st = smem + slot * STAGE;
#pragma unroll
        for (int ks = 0; ks < 2; ++ks) {
            const int ko = ks == 0 ? k0off : k1off;
            bf16x8 b[2];
#pragma unroll
            for (int ni = 0; ni < 2; ++ni) b[ni] = *(const bf16x8*)(st + b_rd + ni * 32 * 64 + ko);
            constexpr int MS = MI >= 2 ? 2 : 1;
#pragma unroll
            for (int m0 = 0; m0 < MI; m0 += MS) {
                bf16x8 a[MS];
#pragma unroll
                for (int mi = 0; mi < MS; ++mi) a[mi] = *(const bf16x8*)(st + a_rd + (m0 + mi) * 32 * 64 + ko);
                __builtin_amdgcn_s_setprio(1);
#pragma unroll
                for (int mi = 0; mi < MS; ++mi)
#pragma unroll
                    for (int ni = 0; ni < 2; ++ni) acc[m0 + mi][ni] = MFMA32(a[mi], b[ni], acc[m0 + mi][ni]);
                __builtin_amdgcn_s_setprio(0);
            }
        }
        slot = slot + 1 == NST ? 0 : slot + 1;
    }
    __syncthreads();
#undef GEMM_FILL
}
#define EPI_FOR(MI_, acc_, BODY)                                                                             \
    {                                                                                                        \
        const int tid_ = opaque_tid(), lane_ = tid_ & 63, wave_ = tid_ >> 6, r_ = lane_ & 31, h_ = lane_ >> 5; \
        _Pragma("unroll") for (int mi_ = 0; mi_ < (MI_); ++mi_) _Pragma("unroll") for (int ni_ = 0; ni_ < 2; ++ni_) { \
            _Pragma("unroll") for (int i_ = 0; i_ < 16; ++i_) {                                              \
            const int row = (wave_ >> 1) * 32 * (MI_) + mi_ * 32 + crow(i_, h_);                             \
            const int col = (wave_ & 1) * 64 + ni_ * 32 + r_;                                                \
            const float v = acc_[mi_][ni_][i_];                                                              \
            BODY                                                                                             \
            if ((i_ & 3) == 3) asm volatile("" ::: "memory");     \
            }                                                                                                \
        }                                                                                                    \
    }

#define EPI_STORE_BF16(MI_, acc_, optr_, ld_)                                                                 \
    {                                                                                                        \
        const int tid_ = opaque_tid(), lane_ = tid_ & 63, wave_ = tid_ >> 6, r_ = lane_ & 31, h_ = lane_ >> 5; \
        const bool odd_ = (r_ & 1) != 0;                                                                     \
        _Pragma("unroll") for (int mi_ = 0; mi_ < (MI_); ++mi_) _Pragma("unroll") for (int ni_ = 0; ni_ < 2; ++ni_) \
            _Pragma("unroll") for (int i_ = 0; i_ < 16; i_ += 2) {                                           \
            const float a0_ = acc_[mi_][ni_][i_], a1_ = acc_[mi_][ni_][i_ + 1];                              \
            const float recv_ = shxf(odd_ ? a0_ : a1_, 1);                                                   \
            const int row_ = (wave_ >> 1) * 32 * (MI_) + mi_ * 32 + crow(i_ + (odd_ ? 1 : 0), h_);           \
            const int col_ = (wave_ & 1) * 64 + ni_ * 32 + (r_ & ~1);                                        \
            *(unsigned*)((optr_) + row_ * (ld_) + col_) = odd_ ? pk2(recv_, a1_) : pk2(a0_, recv_);          \
        }                                                                                                    \
    }

DI void rmsnorm_row_to_bf16(const float* x, const float* g, bf16_t* o, int lane) {
    f32x4 v[8], gq[8];
    float ss = 0.f;
#pragma unroll
    for (int c = 0; c < 8; ++c) { v[c] = *(const f32x4*)(x + c * 256 + lane * 4); gq[c] = *(const f32x4*)(g + c * 256 + lane * 4); }
#pragma unroll
    for (int c = 0; c < 8; ++c) ss += v[c][0] * v[c][0] + v[c][1] * v[c][1] + v[c][2] * v[c][2] + v[c][3] * v[c][3];
    ss = wave_sum(ss);
    const float rstd = rsqrtf(ss * (1.0f / 2048.0f) + EPS);
#pragma unroll
    for (int c = 0; c < 8; ++c) {
        const f32x4 gg = gq[c];
        u32x2 w; w.x = pk2(v[c][0] * rstd * gg[0], v[c][1] * rstd * gg[1]); w.y = pk2(v[c][2] * rstd * gg[2], v[c][3] * rstd * gg[3]);
        *(u32x2*)(o + c * 256 + lane * 4) = w;
    }
}
DI void transpose_tile(const float* W, int N, bf16_t* WT, int kt, int nt, unsigned char* smem) {
    float* tile = (float*)smem;
    const int tid = threadIdx.x;
#pragma unroll
    for (int i = 0; i < 4; ++i) {
        const int k = (tid >> 4) + 16 * i, n4 = (tid & 15) * 4;
        const f32x4 v = *(const f32x4*)(W + (size_t)(kt * 64 + k) * N + nt * 64 + n4);
        tile[k * 65 + n4 + 0] = v[0]; tile[k * 65 + n4 + 1] = v[1]; tile[k * 65 + n4 + 2] = v[2]; tile[k * 65 + n4 + 3] = v[3];
    }
    __syncthreads();
#pragma unroll
    for (int i = 0; i < 2; ++i) {
        const int n = (tid >> 3) + 32 * i, kc = (tid & 7) * 8;
        float f[8];
#pragma unroll
        for (int j = 0; j < 8; ++j) f[j] = tile[(kc + j) * 65 + n];
        *(u32x4*)(WT + (size_t)(nt * 64 + n) * 2048 + kt * 64 + kc) = pack8(f);
    }
    __syncthreads();
}
DI void convert_job(const float* src, bf16_t* dst, int job) {
    const int tid = threadIdx.x;
    f32x4 a[4], b[4];
#pragma unroll
    for (int i = 0; i < 4; ++i) { const size_t idx = (size_t)job * 8192 + i * 2048 + tid * 8; a[i] = *(const f32x4*)(src + idx); b[i] = *(const f32x4*)(src + idx + 4); }
#pragma unroll
    for (int i = 0; i < 4; ++i) {
        const size_t idx = (size_t)job * 8192 + i * 2048 + tid * 8;
        u32x4 w; w.x = pk2(a[i][0], a[i][1]); w.y = pk2(a[i][2], a[i][3]); w.z = pk2(b[i][0], b[i][1]); w.w = pk2(b[i][2], b[i][3]);
        *(u32x4*)(dst + idx) = w;
    }
}
DI void convert8_job(const float* src, unsigned char* dst, int job, float scale) {
    const int tid = threadIdx.x;
#pragma unroll
    for (int i = 0; i < 2; ++i) {
        const size_t idx = (size_t)job * 8192 + i * 4096 + tid * 16;
        u32x4 w;
#pragma unroll
        for (int q = 0; q < 4; ++q) {
            const f32x4 a = *(const f32x4*)(src + idx + 4 * q);
            int t = 0;
            t = __builtin_amdgcn_cvt_pk_fp8_f32(a[0] * scale, a[1] * scale, t, false);
            t = __builtin_amdgcn_cvt_pk_fp8_f32(a[2] * scale, a[3] * scale, t, true);
            w[q] = (unsigned)t;
        }
        *(u32x4*)(dst + idx) = w;
    }
}
DI void convert4_rows(const float* src, unsigned char* dst, float* rowscale, int job) {
    const int tid = threadIdx.x, lane = tid & 63, wave = tid >> 6;
    const int row = job * 4 + wave;
    const float* sp = src + (size_t)row * D;
    f32x4 v[2][4];
    float am = 0.f;
#pragma unroll
    for (int c = 0; c < 2; ++c)
#pragma unroll
        for (int q = 0; q < 4; ++q) {
            v[c][q] = *(const f32x4*)(sp + c * 1024 + lane * 16 + 4 * q);
            am = fmaxf(am, fmaxf(fmaxf(fabsf(v[c][q][0]), fabsf(v[c][q][1])), fmaxf(fabsf(v[c][q][2]), fabsf(v[c][q][3]))));
        }
#pragma unroll
    for (int o = 32; o > 0; o >>= 1) am = fmaxf(am, shxf(am, o));
    const float sc = am > 0.f ? am * (1.0f / 6.0f) : 1.0f, inv = 1.0f / sc;
    if (lane == 0) rowscale[row] = sc;
#pragma unroll
    for (int c = 0; c < 2; ++c) {
        u32x2 w;
#pragma unroll
        for (int d = 0; d < 2; ++d) {
            unsigned t = 0;
            const f32x4 a = v[c][2 * d], b = v[c][2 * d + 1];
            t = __builtin_amdgcn_cvt_scalef32_pk_fp4_f32(t, a[0] * inv, a[1] * inv, 1.0f, 0);
            t = __builtin_amdgcn_cvt_scalef32_pk_fp4_f32(t, a[2] * inv, a[3] * inv, 1.0f, 1);
            t = __builtin_amdgcn_cvt_scalef32_pk_fp4_f32(t, b[0] * inv, b[1] * inv, 1.0f, 2);
            t = __builtin_amdgcn_cvt_scalef32_pk_fp4_f32(t, b[2] * inv, b[3] * inv, 1.0f, 3);
            w[d] = t;
        }
        *(u32x2*)(dst + (size_t)row * 1024 + c * 512 + lane * 8) = w;
    }
}
DI void convert_i4_rows(const float* src, unsigned char* dst, float* rowscale, int job) {
    const int tid = threadIdx.x, lane = tid & 63, wave = tid >> 6;
    const int row = job * 4 + wave;
    const float* sp = src + (size_t)row * D;
    f32x4 v[2][4];
    float am = 0.f;
#pragma unroll
    for (int c = 0; c < 2; ++c)
#pragma unroll
        for (int q = 0; q < 4; ++q) {
            v[c][q] = *(const f32x4*)(sp + c * 1024 + lane * 16 + 4 * q);
            am = fmaxf(am, fmaxf(fmaxf(fabsf(v[c][q][0]), fabsf(v[c][q][1])), fmaxf(fabsf(v[c][q][2]), fabsf(v[c][q][3]))));
        }
#pragma unroll
    for (int o = 32; o > 0; o >>= 1) am = fmaxf(am, shxf(am, o));
    const float sc = am > 0.f ? am * (1.0f / 7.0f) : 1.0f, inv = 1.0f / sc;
    if (lane == 0) rowscale[row] = sc;
#pragma unroll
    for (int c = 0; c < 2; ++c) {
        u32x2 w;
#pragma unroll
        for (int d = 0; d < 2; ++d) {
            unsigned t = 0;
#pragma unroll
            for (int j = 0; j < 8; ++j) {
                const float x = v[c][2 * d + (j >> 2)][j & 3] * inv;
                const int qi = (int)fminf(fmaxf(rintf(x), -7.0f), 7.0f);
                t |= ((unsigned)qi & 0xFu) << (4 * j);
            }
            w[d] = t;
        }
        *(u32x2*)(dst + (size_t)row * 1024 + c * 512 + lane * 8) = w;
    }
}
DI void phase0(const Params& p, unsigned char* smem) {
    const int tid = threadIdx.x, lane = tid & 63, wave = tid >> 6;
    unsigned char* ws = p.ws;
    constexpr int J_NORM = 2432, J_TR = 8960, J_CV = 10528 - 8192, J_ROPE = 66, J_ALL = J_NORM + J_TR + J_CV + J_ROPE;
    for (int job = blockIdx.x; job < J_ALL; job += gridDim.x) {
        if (job >= J_NORM + J_TR + J_CV) {
            const int idx = (job - (J_NORM + J_TR + J_CV)) * 256 + tid;
            const int pos = idx >> 3, i = idx & 7;
            const float inv = exp2f(-(float)i * (18.931568569324174f / 8.0f));
            float sn, cs; sincosf((float)pos * inv, &sn, &cs);
            ((f32x2*)(ws + WS_ROPE))[idx] = (f32x2){cs, sn};
            continue;
        }
        if (job < J_NORM) {
            const int row = job * 4 + wave;
            if (row < MT) {
                const float* x = row < NP ? p.in[I_XP] + (size_t)row * D : p.in[I_XS] + (size_t)(row - NP) * D;
                rmsnorm_row_to_bf16(x, p.in[I_NMIXG], (bf16_t*)(ws + WS_HB) + (size_t)row * D, lane);
            } else {
                const int mr = row - MT;
                rmsnorm_row_to_bf16(p.in[I_MEMP] + (size_t)mr * D, p.in[I_NMEMG], (bf16_t*)(ws + WS_MEMHB) + (size_t)mr * D, lane);
            }
        } else if (job < J_NORM + J_TR) {
            int j = job - J_NORM;
            if (j < 5376) { transpose_tile(p.in[I_WIN], INW, (bf16_t*)(ws + WS_WINT), j / 168, j % 168, smem); }
            else if (j < 5376 + 512) { j -= 5376; transpose_tile(p.in[I_WMEMKV], 1024, (bf16_t*)(ws + WS_WMEMT), j / 16, j % 16, smem); }
            else if (j < 5888 + 1024) { j -= 5888; transpose_tile(p.in[I_WBR], 2048, (bf16_t*)(ws + WS_WBT), j / 32, j % 32, smem); }
            else if (j < 6912 + 1024) { j -= 6912; transpose_tile(p.in[I_WOUT], 2048, (bf16_t*)(ws + WS_WOT), j / 32, j % 32, smem); }
            else { j -= 7936; transpose_tile(p.in[I_PWQ], 2048, (bf16_t*)(ws + WS_WQT), j / 32, j % 32, smem); }
        } else {
            int j = job - J_NORM - J_TR + 8192;
            if (j < 8192) {   }
            else if (j < 9216) { j -= 8192; const int b = j >> 7, jj = j & 127; convert_job(p.in[I_CDK] + (size_t)b * 1048576, (bf16_t*)(ws + WS_KS) + (size_t)b * 1088 * 1024, jj); }
            else if (j < 10240) { j -= 9216; const int b = j >> 7, jj = j & 127; convert_job(p.in[I_CDV] + (size_t)b * 1048576, (bf16_t*)(ws + WS_VS) + (size_t)b * 1088 * 1024, jj); }
            else if (j < 10368) convert_job(p.in[I_CMK], (bf16_t*)(ws + WS_CMK), j - 10240);
            else if (j < 10496) convert_job(p.in[I_CMV], (bf16_t*)(ws + WS_CMV), j - 10368);
            else convert_job(p.in[I_PSK], (bf16_t*)(ws + WS_SKB), j - 10496);
        }
    }
}

DI void phase1(const Params& p, unsigned char* smem) {
    unsigned char* ws = p.ws;
    const bf16_t* Hb = (const bf16_t*)(ws + WS_HB);
    const bf16_t* WinT = (const bf16_t*)(ws + WS_WINT);
    bf16_t* P = (bf16_t*)(ws + WS_P);
    for_tiles(34, 84, [&](int tm, int tn) {
        f32x16 acc[4][2];
#pragma unroll
        for (int mi = 0; mi < 4; ++mi) acc[mi][0] = acc[mi][1] = zero16();
        gemm_kloop<4, 3>(acc, Hb + (size_t)tm * 256 * D, D, WinT + (size_t)tn * 128 * D, D, 64, smem);
        bf16_t* o = P + (size_t)tm * 256 * INW + tn * 128;
        EPI_STORE_BF16(4, acc, o, INW)
    });
    const bf16_t* MemHb = (const bf16_t*)(ws + WS_MEMHB);
    const bf16_t* WmemT = (const bf16_t*)(ws + WS_WMEMT);
    float* MemKV = (float*)(ws + WS_MEMKV);
    for (int t = gridDim.x - 1 - blockIdx.x; t < 32; t += gridDim.x) {
        const int tm = t >> 3, tn = t & 7;
        f32x16 acc[4][2];
#pragma unroll
        for (int mi = 0; mi < 4; ++mi) acc[mi][0] = acc[mi][1] = zero16();
        gemm_kloop<4, 3>(acc, MemHb + (size_t)tm * 256 * D, D, WmemT + (size_t)tn * 128 * D, D, 64, smem);
        float* o = MemKV + (size_t)tm * 256 * 1024 + tn * 128;
        EPI_FOR(4, acc, { o[row * 1024 + col] = v; })
    }
}

DI void qk_norm_rope(float* v, f32x4 g0, f32x4 g1, int gl, const float* cs, const float* sn, float scale) {
    float ss = 0.f;
#pragma unroll
    for (int i = 0; i < 8; ++i) ss += v[i] * v[i];
    ss += shxf(ss, 1); ss += shxf(ss, 2); ss += shxf(ss, 4);
    const float rstd = rsqrtf(ss * (1.0f / 64.0f) + EPS);
    float y[8];
#pragma unroll
    for (int i = 0; i < 4; ++i) { y[i] = v[i] * rstd * g0[i]; y[4 + i] = v[4 + i] * rstd * g1[i]; }
#pragma unroll
    for (int i = 0; i < 8; ++i) {
        const float pr = shxf(y[i], 1);
        float o = y[i];
        if (gl == 0) o = y[i] * cs[i] - pr * sn[i];
        else if (gl == 1) o = y[i] * cs[i] + pr * sn[i];
        v[i] = o * scale;
    }
}
DI void phase2(const Params& p, unsigned char* smem) {
    const int tid = threadIdx.x, lane = tid & 63, wave = tid >> 6;
    unsigned char* ws = p.ws;
    bf16_t* P = (bf16_t*)(ws + WS_P);
    float* out = p.out;
    constexpr int J_TOK = 2176, J_MEM = 256;
    for (int job = blockIdx.x; job < J_TOK + J_MEM; job += gridDim.x) {
        if (job < J_TOK) {
            const int row = job * 4 + wave;
            const bool samp = row >= NP;
            const int rs = row - NP;
            const int pos = samp ? 1024 + (rs & 63) : (row & 2047);
            bf16_t* pr = P + (size_t)row * INW;
            u32x4 in[9];
#pragma unroll
            for (int c = 0; c < 9; ++c) in[c] = *(const u32x4*)(pr + c * 512 + lane * 8);
            float cs[8], sn[8];
            {
                const f32x4* rt = (const f32x4*)(ws + WS_ROPE) + pos * 4;
#pragma unroll
                for (int i = 0; i < 4; ++i) { const f32x4 v = rt[i]; cs[2 * i] = v[0]; sn[2 * i] = v[1]; cs[2 * i + 1] = v[2]; sn[2 * i + 1] = v[3]; }
            }
            const int gl = lane & 7;
            const f32x4 qg0 = *(const f32x4*)(p.in[I_QNG] + gl * 8), qg1 = *(const f32x4*)(p.in[I_QNG] + gl * 8 + 4);
            const f32x4 kg0 = *(const f32x4*)(p.in[I_KNG] + gl * 8), kg1 = *(const f32x4*)(p.in[I_KNG] + gl * 8 + 4);
            const f32x4 lg0 = *(const f32x4*)(p.in[I_CMLNG] + lane * 8), lg1 = *(const f32x4*)(p.in[I_CMLNG] + lane * 8 + 4);
            const f32x4 lb0 = *(const f32x4*)(p.in[I_CMLNB] + lane * 8), lb1 = *(const f32x4*)(p.in[I_CMLNB] + lane * 8 + 4);
            const f32x4 mg0 = *(const f32x4*)(p.in[I_MQNG] + (lane & 15) * 8), mg1 = *(const f32x4*)(p.in[I_MQNG] + (lane & 15) * 8 + 4);
#pragma unroll
            for (int ps = 0; ps < 2; ++ps) {
                float f[8]; unpack8(in[ps], f);
                qk_norm_rope(f, qg0, qg1, gl, cs, sn, 0.125f * LOG2E);
                *(u32x4*)(pr + OFF_Q + ps * 512 + lane * 8) = pack8(f);
            }
#pragma unroll
            for (int ps = 0; ps < 2; ++ps) {
                const int c = ps * 512 + lane * 8;
                float f[8]; unpack8(in[2 + ps], f);
                qk_norm_rope(f, kg0, kg1, gl, cs, sn, 1.0f);
                float* ko = samp ? out + O_KS + (size_t)rs * 1024 + c : out + O_KP + (size_t)row * 1024 + c;
                *(f32x4*)ko = (f32x4){f[0], f[1], f[2], f[3]};
                *(f32x4*)(ko + 4) = (f32x4){f[4], f[5], f[6], f[7]};
                const u32x4 w = pack8(f);
                if (samp) *(u32x4*)((bf16_t*)(ws + WS_KS) + ((size_t)(rs >> 6) * 1088 + 1024 + (rs & 63)) * 1024 + c) = w;
                else *(u32x4*)(pr + OFF_K + c) = w;
            }
#pragma unroll
            for (int ps = 0; ps < 2; ++ps) {
                const int c = ps * 512 + lane * 8;
                const u32x4 w = in[4 + ps];
                float f[8]; unpack8(w, f);
                float* vo = samp ? out + O_VS + (size_t)rs * 1024 + c : out + O_VP + (size_t)row * 1024 + c;
                *(f32x4*)vo = (f32x4){f[0], f[1], f[2], f[3]};
                *(f32x4*)(vo + 4) = (f32x4){f[4], f[5], f[6], f[7]};
                if (samp) *(u32x4*)((bf16_t*)(ws + WS_VS) + ((size_t)(rs >> 6) * 1088 + 1024 + (rs & 63)) * 1024 + c) = w;
            }
            {
                float f[8]; unpack8(in[6], f);
#pragma unroll
                for (int i = 0; i < 8; ++i) f[i] = gelu_fast(f[i]);
                *(u32x4*)(pr + OFF_U + lane * 8) = pack8(f);
            }
            {
                const int c = lane * 8;
                float f[8]; unpack8(in[7], f);
                float sm = 0.f;
#pragma unroll
                for (int i = 0; i < 8; ++i) { f[i] = gelu_fast(f[i]); sm += f[i]; }
                const float mu = wave_sum(sm) * (1.0f / 512.0f);
                float q = 0.f;
#pragma unroll
                for (int i = 0; i < 8; ++i) { f[i] -= mu; q += f[i] * f[i]; }
                const float rstd = rsqrtf(wave_sum(q) * (1.0f / 512.0f) + EPS);
#pragma unroll
                for (int i = 0; i < 4; ++i) { f[i] = f[i] * rstd * lg0[i] + lb0[i]; f[4 + i] = f[4 + i] * rstd * lg1[i] + lb1[i]; }
                *(u32x4*)(pr + OFF_VC + c) = pack8(f);
                if (samp) {
                    float* co = out + O_CVS + (size_t)rs * 512 + c;
                    *(f32x4*)co = (f32x4){f[0], f[1], f[2], f[3]};
                    *(f32x4*)(co + 4) = (f32x4){f[4], f[5], f[6], f[7]};
                }
            }
            {
                float f[8]; unpack8(in[8], f);
                float ss = 0.f;
#pragma unroll
                for (int i = 0; i < 8; ++i) ss += f[i] * f[i];
                ss += shxf(ss, 1); ss += shxf(ss, 2); ss += shxf(ss, 4); ss += shxf(ss, 8);
                const float rstd = rsqrtf(ss * (1.0f / 128.0f) + EPS) * (0.08838834764831845f * LOG2E);
#pragma unroll
                for (int i = 0; i < 4; ++i) { f[i] = f[i] * rstd * mg0[i]; f[4 + i] = f[4 + i] * rstd * mg1[i]; }
                *(u32x4*)(pr + OFF_QM + lane * 8) = pack8(f);
            }
        } else {
            const int row = (job - J_TOK) * 4 + wave;
            const float* src = (const float*)(ws + WS_MEMKV) + (size_t)row * 1024;
            {
                const int c = lane * 8;
                const f32x4 a = *(const f32x4*)(src + c), b = *(const f32x4*)(src + c + 4);
                float f[8] = {a[0], a[1], a[2], a[3], b[0], b[1], b[2], b[3]};
                float ss = 0.f;
#pragma unroll
                for (int i = 0; i < 8; ++i) ss += f[i] * f[i];
                ss += shxf(ss, 1); ss += shxf(ss, 2); ss += shxf(ss, 4); ss += shxf(ss, 8);
                const float rstd = rsqrtf(ss * (1.0f / 128.0f) + EPS);
                const float* g = p.in[I_MKNG] + (lane & 15) * 8;
#pragma unroll
                for (int i = 0; i < 8; ++i) f[i] = f[i] * rstd * g[i];
                float* ko = out + O_MKP + (size_t)row * 512 + c;
                *(f32x4*)ko = (f32x4){f[0], f[1], f[2], f[3]};
                *(f32x4*)(ko + 4) = (f32x4){f[4], f[5], f[6], f[7]};
                *(u32x4*)((bf16_t*)(ws + WS_MEMKB) + (size_t)row * 512 + c) = pack8(f);
            }
            {
                const int c = lane * 8;
                const f32x4 a = *(const f32x4*)(src + 512 + c), b = *(const f32x4*)(src + 512 + c + 4);
                float f[8] = {a[0], a[1], a[2], a[3], b[0], b[1], b[2], b[3]};
                float* vo = out + O_MVP + (size_t)row * 512 + c;
                *(f32x4*)vo = a; *(f32x4*)(vo + 4) = b;
                *(u32x4*)((bf16_t*)(ws + WS_MEMVB) + (size_t)row * 512 + c) = pack8(f);
            }
        }
    }
}

template <int DQK, int KW, bool PF>
DI void attn_main(const bf16_t* Qw, int qstride, const bf16_t* Kg, size_t kstride, const bf16_t* Vg, size_t vstride, int nkt, int kcol, int vcol,
                  unsigned char* smem, f32x16 (&o)[4], float& m_run, float& l_run) {
    constexpr int KROW = KW * 2 + 16, VROW = KW * 2 + 32, VOFF = 64 * KROW, CPR = KW / 8, NCH = KW / 32, NKS = DQK / 16;
    const int tid = opaque_tid(), lane = tid & 63, r = lane & 31, h = lane >> 5;
    bf16x8 qf[NKS];
#pragma unroll
    for (int ks = 0; ks < NKS; ++ks) qf[ks] = *(const bf16x8*)(Qw + (size_t)r * qstride + ks * 16 + h * 8);
#pragma unroll
    for (int dt = 0; dt < 4; ++dt) o[dt] = zero16();
    m_run = -INFINITY; l_run = 0.f;
    u32x4 rk[NCH], rv[PF ? NCH : 1];
    constexpr int RPI = 256 / CPR;
    const unsigned kvo = (unsigned)((tid / CPR) * (int)kstride * 2 + (tid % CPR) * 16);
    const unsigned vvo = (unsigned)((tid / CPR) * (int)vstride * 2 + (tid % CPR) * 16);
    const int wlo = (tid / CPR) * KROW + (tid % CPR) * 16, wlv = VOFF + (tid / CPR) * VROW + (tid % CPR) * 16;
    if (PF) {
#pragma unroll
        for (int i = 0; i < NCH; ++i) { rk[i] = *(const u32x4*)((const char*)(Kg + (size_t)(i * RPI) * kstride) + kvo); rv[i] = *(const u32x4*)((const char*)(Vg + (size_t)(i * RPI) * vstride) + vvo); }
    }
    const int gi = lane >> 4, i16 = lane & 15, tq = i16 >> 2, tp = i16 & 3;
    const unsigned char* vbase = smem + VOFF + (4 * h + tq) * VROW + (vcol + 16 * (gi & 1)) * 2 + 8 * tp;
    const unsigned char* kbase = smem + r * KROW + (kcol + h * 8) * 2;
#pragma unroll 1
    for (int kt = 0; kt < nkt; ++kt) {
        if (!PF) {
#pragma unroll
            for (int i = 0; i < NCH; ++i) rk[i] = *(const u32x4*)((const char*)(Kg + (size_t)(kt * 64 + i * RPI) * kstride) + kvo);
        }
        __syncthreads();
        if (PF) {
#pragma unroll
            for (int i = 0; i < NCH; ++i) { *(u32x4*)(smem + wlo + i * RPI * KROW) = rk[i]; *(u32x4*)(smem + wlv + i * RPI * VROW) = rv[i]; }
        } else {
#pragma unroll
            for (int i = 0; i < NCH; ++i) *(u32x4*)(smem + wlo + i * RPI * KROW) = rk[i];
#pragma unroll
            for (int i = 0; i < NCH; ++i) rk[i] = *(const u32x4*)((const char*)(Vg + (size_t)(kt * 64 + i * RPI) * vstride) + vvo);
#pragma unroll
            for (int i = 0; i < NCH; ++i) *(u32x4*)(smem + wlv + i * RPI * VROW) = rk[i];
        }
        __syncthreads();
        if (PF && kt + 1 < nkt) {
#pragma unroll
            for (int i = 0; i < NCH; ++i) { rk[i] = *(const u32x4*)((const char*)(Kg + (size_t)((kt + 1) * 64 + i * RPI) * kstride) + kvo); rv[i] = *(const u32x4*)((const char*)(Vg + (size_t)((kt + 1) * 64 + i * RPI) * vstride) + vvo); }
        }
        f32x16 x[2];
#pragma unroll
        for (int mt = 0; mt < 2; ++mt) {
            bf16x8 kf[NKS];
#pragma unroll
            for (int ks = 0; ks < NKS; ++ks) kf[ks] = *(const bf16x8*)(kbase + mt * 32 * KROW + ks * 32);
            x[mt] = zero16();
#pragma unroll
            for (int ks = 0; ks < NKS; ++ks) x[mt] = MFMA32(kf[ks], qf[ks], x[mt]);
        }
        bf16x8 av[2][4];
#pragma unroll
        for (int f = 0; f < 4; ++f) { const int kb = 32 * (f >> 1) + 16 * (f & 1); av[0][f] = tr_pair(vbase + kb * VROW, vbase + (kb + 8) * VROW); }
        float mx = x[0][0];
#pragma unroll
        for (int mt = 0; mt < 2; ++mt)
#pragma unroll
            for (int i = 0; i < 16; ++i) mx = fmaxf(mx, x[mt][i]);
        mx = fmaxf(mx, shxf(mx, 32));
        const float mnew = fmaxf(m_run, mx);
        const float alpha = __builtin_amdgcn_exp2f(m_run - mnew);
        m_run = mnew;
        float psum = 0.f;
#pragma unroll
        for (int mt = 0; mt < 2; ++mt)
#pragma unroll
            for (int i = 0; i < 16; ++i) { x[mt][i] = __builtin_amdgcn_exp2f(x[mt][i] - mnew); psum += x[mt][i]; }
        l_run = l_run * alpha + psum;
#pragma unroll
        for (int dt = 0; dt < 4; ++dt) o[dt] = o[dt] * alpha;
        bf16x8 pb[2][2];
#pragma unroll
        for (int mt = 0; mt < 2; ++mt)
#pragma unroll
            for (int s = 0; s < 2; ++s) {
                u32x4 w;
                w.x = pk2(x[mt][8 * s + 0], x[mt][8 * s + 1]); w.y = pk2(x[mt][8 * s + 2], x[mt][8 * s + 3]);
                w.z = pk2(x[mt][8 * s + 4], x[mt][8 * s + 5]); w.w = pk2(x[mt][8 * s + 6], x[mt][8 * s + 7]);
                pb[mt][s] = __builtin_bit_cast(bf16x8, w);
            }
#pragma unroll
        for (int dt = 0; dt < 4; ++dt) {
            if (dt < 3) {
#pragma unroll
                for (int f = 0; f < 4; ++f) { const int kb = 32 * (f >> 1) + 16 * (f & 1); av[(dt + 1) & 1][f] = tr_pair(vbase + kb * VROW + (dt + 1) * 64, vbase + (kb + 8) * VROW + (dt + 1) * 64); }
            }
#pragma unroll
            for (int f = 0; f < 4; ++f) o[dt] = MFMA32(av[dt & 1][f], pb[f >> 1][f & 1], o[dt]);
        }
    }
}

DI void diff_item(const Params& p, unsigned char* smem, float lam, bool samp, int b, int hh, int c) {
    unsigned char* ws = p.ws;
    const bf16_t* P = (const bf16_t*)(ws + WS_P);
    const int tid = opaque_tid(), lane = tid & 63, wave = tid >> 6, r = lane & 31, h = lane >> 5;
    const int comp = wave >> 1, half = wave & 1;
    const int row0 = samp ? NP + b * 64 : b * 2048 + c * 64;
    const bf16_t* Qw = P + (size_t)(row0 + 32 * half) * INW + OFF_Q + hh * 128 + comp * 64;
    const bf16_t *Kg, *Vg; size_t kst; int nkt;
    if (samp) { Kg = (const bf16_t*)(ws + WS_KS) + (size_t)b * 1088 * 1024 + hh * 128; Vg = (const bf16_t*)(ws + WS_VS) + (size_t)b * 1088 * 1024 + hh * 128; kst = 1024; nkt = 17; }
    else { Kg = P + (size_t)b * 2048 * INW + OFF_K + hh * 128; Vg = P + (size_t)b * 2048 * INW + OFF_V + hh * 128; kst = INW; nkt = c + 1; }
    f32x16 o[4]; float m_run, l_run;
    attn_main<64, 128, true>(Qw, INW, Kg, kst, Vg, kst, nkt, comp * 64, 0, smem, o, m_run, l_run);
    const float inv = 1.0f / (l_run + shxf(l_run, 32));
    float* xch = (float*)smem;
    __syncthreads();
    if (comp == 1) {
#pragma unroll
        for (int dt = 0; dt < 4; ++dt)
#pragma unroll
            for (int ig = 0; ig < 4; ++ig) {
                f32x4 w = {o[dt][4 * ig] * inv, o[dt][4 * ig + 1] * inv, o[dt][4 * ig + 2] * inv, o[dt][4 * ig + 3] * inv};
                *(f32x4*)(xch + (32 * half + r) * 132 + 32 * dt + 8 * ig + 4 * h) = w;
            }
    }
    __syncthreads();
    if (comp == 0) {
        float ss = 0.f;
#pragma unroll
        for (int dt = 0; dt < 4; ++dt)
#pragma unroll
            for (int ig = 0; ig < 4; ++ig) {
                const f32x4 w = *(const f32x4*)(xch + (32 * half + r) * 132 + 32 * dt + 8 * ig + 4 * h);
#pragma unroll
                for (int j = 0; j < 4; ++j) { const float v = o[dt][4 * ig + j] * inv - lam * w[j]; o[dt][4 * ig + j] = v; ss += v * v; }
            }
        ss += shxf(ss, 32);
        const float rstd = rsqrtf(ss * (1.0f / 128.0f) + EPS) * 0.8f;
        bf16_t* mo = (bf16_t*)(ws + WS_MIXIN) + (size_t)(row0 + 32 * half + r) * D + hh * 128;
        const float* og = p.in[I_OUTG];
        f32x4 gq[4][4];
#pragma unroll
        for (int dt = 0; dt < 4; ++dt)
#pragma unroll
            for (int ig = 0; ig < 4; ++ig) gq[dt][ig] = *(const f32x4*)(og + 32 * dt + 8 * ig + 4 * h);
#pragma unroll
        for (int dt = 0; dt < 4; ++dt)
#pragma unroll
            for (int ig = 0; ig < 4; ++ig) {
                const int d0 = 32 * dt + 8 * ig + 4 * h;
                const f32x4 g = gq[dt][ig];
                u32x2 w; w.x = pk2(o[dt][4 * ig] * rstd * g[0], o[dt][4 * ig + 1] * rstd * g[1]); w.y = pk2(o[dt][4 * ig + 2] * rstd * g[2], o[dt][4 * ig + 3] * rstd * g[3]);
                *(u32x2*)(mo + d0) = w;
            }
    }
}

DI void mem_item(const Params& p, unsigned char* smem, int rt, int hp) {
    unsigned char* ws = p.ws;
    const bf16_t* P = (const bf16_t*)(ws + WS_P);
    const int tid = opaque_tid(), lane = tid & 63, wave = tid >> 6, r = lane & 31, h = lane >> 5;
    const int head = 2 * hp + (wave >> 1), half = wave & 1;
    const int row0 = rt * 64;
    const bf16_t *Kg, *Vg;
    if (rt < 128) { const int b = rt >> 5; Kg = (const bf16_t*)(ws + WS_MEMKB) + (size_t)b * 256 * 512 + hp * 256; Vg = (const bf16_t*)(ws + WS_MEMVB) + (size_t)b * 256 * 512 + hp * 256; }
    else { const int b = rt - 128; Kg = (const bf16_t*)(ws + WS_CMK) + (size_t)b * 256 * 512 + hp * 256; Vg = (const bf16_t*)(ws + WS_CMV) + (size_t)b * 256 * 512 + hp * 256; }
    const bf16_t* Qw = P + (size_t)(row0 + 32 * half) * INW + OFF_QM + head * 128;
    f32x16 o[4]; float m_run, l_run;
    attn_main<128, 256, false>(Qw, INW, Kg, 512, Vg, 512, 4, (wave >> 1) * 128, (wave >> 1) * 128, smem, o, m_run, l_run);
    const float inv = 1.0f / (l_run + shxf(l_run, 32));
    bf16_t* mo = (bf16_t*)(ws + WS_MIXIN) + (size_t)(row0 + 32 * half + r) * D + 1536 + head * 128;
#pragma unroll
    for (int dt = 0; dt < 4; ++dt)
#pragma unroll
        for (int ig = 0; ig < 4; ++ig) {
            const int d0 = 32 * dt + 8 * ig + 4 * h;
            u32x2 w; w.x = pk2(o[dt][4 * ig] * inv, o[dt][4 * ig + 1] * inv); w.y = pk2(o[dt][4 * ig + 2] * inv, o[dt][4 * ig + 3] * inv);
            *(u32x2*)(mo + d0) = w;
        }
}

DI void mlp_item(const Params& p, unsigned char* smem, int idx) {
    unsigned char* ws = p.ws;
    const bf16_t* P = (const bf16_t*)(ws + WS_P);
    const int tid = opaque_tid(), lane = tid & 63, wave = tid >> 6, r = lane & 31, h = lane >> 5;
    int row0, L, g;
    if (idx < 256) { const int b = idx >> 6, ch = (idx >> 2) & 15; g = idx & 3; row0 = b * 2048 + ch * 128; L = 128; }
    else { const int j = idx - 256; g = j & 3; row0 = NP + (j >> 2) * 64; L = 64; }
    constexpr int VROW = 288;
    __syncthreads();
    for (int c = tid; c < L * 16; c += 256) {
        const int s = c >> 4, cc = c & 15;
        *(u32x4*)(smem + s * VROW + cc * 16) = *(const u32x4*)(P + (size_t)(row0 + s) * INW + OFF_VC + g * 128 + cc * 8);
    }
    __syncthreads();
    if (32 * wave < L) {
        const int t = 32 * wave + r;
        const float* wsrow = p.in[I_CMWS] + ((size_t)g * 128 + t) * 128;
        f32x16 acc[4];
#pragma unroll
        for (int mt = 0; mt < 4; ++mt) acc[mt] = zero16();
        const int gi = lane >> 4, i16 = lane & 15, tq = i16 >> 2, tp = i16 & 3;
        const unsigned char* vbase = smem + (4 * h + tq) * VROW + (16 * (gi & 1)) * 2 + 8 * tp;
        const int nks = 2 * wave + 2;
        f32x4 wa[8], wb[8];
#pragma unroll
        for (int ks = 0; ks < 8; ++ks)
            if (ks < nks) { const int s0 = 16 * ks + 4 * h; wa[ks] = *(const f32x4*)(wsrow + s0); wb[ks] = *(const f32x4*)(wsrow + s0 + 8); }
#pragma unroll
        for (int ks = 0; ks < 8; ++ks)
            if (ks < nks) {
                const int s0 = 16 * ks + 4 * h;
                f32x4 w0 = wa[ks], w1 = wb[ks];
#pragma unroll
                for (int j = 0; j < 4; ++j) { if (s0 + j > t) w0[j] = 0.f; if (s0 + 8 + j > t) w1[j] = 0.f; }
                u32x4 bw; bw.x = pk2(w0[0], w0[1]); bw.y = pk2(w0[2], w0[3]); bw.z = pk2(w1[0], w1[1]); bw.w = pk2(w1[2], w1[3]);
                const bf16x8 bfrag = __builtin_bit_cast(bf16x8, bw);
#pragma unroll
                for (int mt = 0; mt < 4; ++mt) {
                    const bf16x8 a = tr_pair(vbase + (16 * ks) * VROW + mt * 64, vbase + (16 * ks + 8) * VROW + mt * 64);
                    acc[mt] = MFMA32(a, bfrag, acc[mt]);
                }
            }
        const float bias = p.in[I_CMBS][g * 128 + t];
        const bf16_t* up = P + (size_t)(row0 + t) * INW + OFF_U + g * 128;
        bf16_t* mo = (bf16_t*)(ws + WS_MIXIN) + (size_t)(row0 + t) * D + 1024 + g * 128;
        u32x2 uv[4][4];
#pragma unroll
        for (int mt = 0; mt < 4; ++mt)
#pragma unroll
            for (int ig = 0; ig < 4; ++ig) uv[mt][ig] = *(const u32x2*)(up + 32 * mt + 8 * ig + 4 * h);
#pragma unroll
        for (int mt = 0; mt < 4; ++mt)
#pragma unroll
            for (int ig = 0; ig < 4; ++ig) {
                const int c0 = 32 * mt + 8 * ig + 4 * h;
                const u32x2 u = uv[mt][ig];
                u32x2 w;
                w.x = pk2(bflo(u.x) * (acc[mt][4 * ig] + bias), bfhi(u.x) * (acc[mt][4 * ig + 1] + bias));
                w.y = pk2(bflo(u.y) * (acc[mt][4 * ig + 2] + bias), bfhi(u.y) * (acc[mt][4 * ig + 3] + bias));
                *(u32x2*)(mo + c0) = w;
            }
    }
}

DI void phase3(const Params& p, unsigned char* smem) {
    __shared__ int4 s_p3;
    int& s_item = s_p3.x;
    float& s_lam = *(float*)&s_p3.y;
    const int tid = threadIdx.x;
    if (tid < 64) {
        float a = p.in[I_LQ1][tid] * p.in[I_LK1][tid], b = p.in[I_LQ2][tid] * p.in[I_LK2][tid];
        a = wave_sum(a); b = wave_sum(b);
        if (tid == 0) s_lam = expf(a) - expf(b) + 0.2f;
    }
    __syncthreads();
    const float lam = s_lam;
    unsigned* ctr = (unsigned*)(p.ws + WS_CTL);
    constexpr int N_ATT = 1648, N_CONV = 1024, N_ITEMS = N_ATT + N_CONV;
    for (;;) {
        __syncthreads();
        if (tid == 0) s_item = (int)atomicAdd(ctr, 1u);
        __syncthreads();
        const int id = __builtin_amdgcn_readfirstlane(s_item);
        if (id >= N_ITEMS) break;
        int it;
        if (id < 2 * N_CONV) {
            if ((id & 1) == 0) {
                const int cj = (id >> 1) * 8;
#pragma unroll 1
                for (int q = 0; q < 8; ++q) {
                    const int j = cj + q;
                    if (j < 4096) convert_i4_rows(p.in[I_PU], p.ws + WS_UB, (float*)(p.ws + WS_USC), j);
                    else convert4_rows(p.in[I_PV], p.ws + WS_VB, (float*)(p.ws + WS_VSC), j - 4096);
                }
                continue;
            }
            it = id >> 1;
        } else it = id - N_CONV;
        if (it < 480) { diff_item(p, smem, lam, false, (it & 31) >> 3, it & 7, 31 - (it >> 5)); }
        else if (it < 544) { const int j = it - 480; diff_item(p, smem, lam, true, j >> 3, j & 7, 0); }
        else if (it < 832) { const int j = it - 544; diff_item(p, smem, lam, false, (j & 31) >> 3, j & 7, 16 - (j >> 5)); }
        else if (it < 1104) { const int j = it - 832; mem_item(p, smem, j >> 1, j & 1); }
        else if (it < 1392) { mlp_item(p, smem, it - 1104); }
        else { const int j = it - 1392; diff_item(p, smem, lam, false, (j & 31) >> 3, j & 7, 7 - (j >> 5)); }
    }
}

template <int MI> struct RingDepth { static constexpr int v = MI == 4 ? 3 : 4; };
template <int MI> DI void p4_tile(const Params& p, unsigned char* smem, int row0, int tn) {
    unsigned char* ws = p.ws;
    const bf16_t* mixin = (const bf16_t*)(ws + WS_MIXIN);
    const bf16_t* WbT = (const bf16_t*)(ws + WS_WBT);
    const bf16_t* P = (const bf16_t*)(ws + WS_P);
    bf16_t* merged = (bf16_t*)(ws + WS_MERGED);
    f32x16 tot[MI][2];
#pragma unroll
    for (int mi = 0; mi < MI; ++mi) tot[mi][0] = tot[mi][1] = zero16();
    const float* bgp = p.in[I_BGATE] + tn * 128;
    constexpr int GROW = 272;
#pragma unroll 1
    for (int seg = 0; seg < 3; ++seg) {
        const int k0 = seg == 0 ? 0 : (seg == 1 ? 1024 : 1536), nk = seg == 0 ? 32 : 16;
        f32x16 acc[MI][2];
#pragma unroll
        for (int mi = 0; mi < MI; ++mi) acc[mi][0] = acc[mi][1] = zero16();
        const int gtid = opaque_tid();
        const bf16_t* gsrc = P + (size_t)row0 * INW + OFF_G + seg * 2048 + tn * 128;
        u32x4 gv[MI * 4];
#pragma unroll
        for (int i = 0; i < MI * 4; ++i) { const int c = gtid + 256 * i; gv[i] = *(const u32x4*)(gsrc + (c >> 4) * INW + (c & 15) * 8); }
        gemm_kloop<MI, RingDepth<MI>::v>(acc, mixin + (size_t)row0 * D + k0, D, WbT + (size_t)tn * 128 * D + k0, D, nk, smem);
#pragma unroll
        for (int i = 0; i < MI * 4; ++i) { const int c = gtid + 256 * i; *(u32x4*)(smem + (c >> 4) * GROW + (c & 15) * 16) = gv[i]; }
        __syncthreads();
        const float* bseg = bgp + seg * 2048;
        EPI_FOR(MI, acc, {
            const float gl = bf2f(*(const bf16_t*)(smem + row * GROW + col * 2)) + bseg[col];
            const float gate = __builtin_amdgcn_rcpf(1.0f + __builtin_amdgcn_exp2f(gl * -LOG2E));
            tot[mi_][ni_][i_] += gate * v;
        })
        __syncthreads();
    }
    bf16_t* o = merged + (size_t)row0 * D + tn * 128;
    EPI_FOR(MI, tot, { o[row * D + col] = f2bf(v); })
}
DI void phase4(const Params& p, unsigned char* smem) {
    for_tiles(64, 16, [&](int tm, int tn) { p4_tile<2>(p, smem, tm * 128, tn); });
    for_tiles(8, 16, [&](int tm, int tn) { p4_tile<1>(p, smem, NP + tm * 64, tn); });
}

template <int MI> DI void p5_tile(const Params& p, unsigned char* smem, int row0, int tn) {
    unsigned char* ws = p.ws;
    const bf16_t* merged = (const bf16_t*)(ws + WS_MERGED);
    const bf16_t* WoT = (const bf16_t*)(ws + WS_WOT);
    bf16_t* x1g = (bf16_t*)(ws + WS_X1G);
    f32x16 acc[MI][2];
#pragma unroll
    for (int mi = 0; mi < MI; ++mi) acc[mi][0] = acc[mi][1] = zero16();
    gemm_kloop<MI, RingDepth<MI>::v>(acc, merged + (size_t)row0 * D, D, WoT + (size_t)tn * 128 * D, D, 64, smem);
    const float* xin = (row0 < NP ? p.in[I_XP] + (size_t)row0 * D : p.in[I_XS] + (size_t)(row0 - NP) * D) + tn * 128;
    float* y = p.out + O_Y + (size_t)row0 * D + tn * 128;
    bf16_t* xg = x1g + (size_t)row0 * D + tn * 128;
    const float* gfp = p.in[I_NFFNG] + tn * 128;
    {
        const int tid_ = opaque_tid(), lane_ = tid_ & 63, wave_ = tid_ >> 6, r_ = lane_ & 31, h_ = lane_ >> 5;
#pragma unroll
        for (int mi = 0; mi < MI; ++mi)
#pragma unroll
            for (int ni = 0; ni < 2; ++ni) {
                const int col = (wave_ & 1) * 64 + ni * 32 + r_;
                const float gcol = gfp[col];
                float xv[16];
#pragma unroll
                for (int i = 0; i < 16; ++i) xv[i] = xin[((wave_ >> 1) * 32 * MI + mi * 32 + crow(i, h_)) * D + col];
#pragma unroll
                for (int i = 0; i < 16; ++i) {
                    const int row = (wave_ >> 1) * 32 * MI + mi * 32 + crow(i, h_);
                    const float x1 = xv[i] + acc[mi][ni][i];
                    y[row * D + col] = x1;
                    xg[row * D + col] = f2bf(x1 * gcol);
                }
                asm volatile("" ::: "memory");
            }
    }
}
DI void phase5(const Params& p, unsigned char* smem) {
    for_tiles(32, 16, [&](int tm, int tn) { p5_tile<4>(p, smem, tm * 256, tn); });
    for_tiles(8, 16, [&](int tm, int tn) { p5_tile<1>(p, smem, NP + tm * 64, tn); });
}

DI void phase6(const Params& p, unsigned char* smem) {
    unsigned char* ws = p.ws;
    const bf16_t* x1g = (const bf16_t*)(ws + WS_X1G);
    const bf16_t* WqT = (const bf16_t*)(ws + WS_WQT);
    const bf16_t* SK = (const bf16_t*)(ws + WS_SKB);
    float* sc = (float*)(ws + WS_SCORES);
    constexpr int STAGE = 16384, A_BYTES = 8192;
    for_tiles(68, 16, [&](int tm, int tn) {
        f32x16 acc[2][2];
        acc[0][0] = acc[0][1] = acc[1][0] = acc[1][1] = zero16();
        gemm_kloop<2, 4>(acc, x1g + (size_t)tm * 128 * D, D, WqT + (size_t)tn * 128 * D, D, 64, smem);
        const int tid = opaque_tid(), lane = tid & 63, wave = tid >> 6, wm = wave >> 1, wn = wave & 1, r = lane & 31, h = lane >> 5;
        {
            const int frow = lane >> 2, fslot = lane & 3;
            const bf16_t* Bg = SK + (size_t)tn * 128 * 128;
#pragma unroll
            for (int sl = 0; sl < 4; ++sl)
#pragma unroll
                for (int i = 0; i < 2; ++i) {
                    const int R = (wave * 2 + i) * 16 + frow;
                    __builtin_amdgcn_global_load_lds((GLB1 const void*)(Bg + R * 128 + (fslot ^ ((R >> 2) & 3)) * 8 + sl * 32), (LDS3 void*)(smem + sl * STAGE + A_BYTES + (wave * 2 + i) * 1024), 16, 0, 0);
                }
        }
#pragma unroll
        for (int mi = 0; mi < 2; ++mi)
#pragma unroll
            for (int ni = 0; ni < 2; ++ni)
#pragma unroll
                for (int i = 0; i < 16; ++i) {
                    const int row = wm * 64 + mi * 32 + crow(i, h), k = wn * 64 + ni * 32 + r;
                    *(bf16_t*)(smem + (k >> 5) * STAGE + row * 64 + ((((k & 31) >> 3) ^ ((row >> 2) & 3)) * 16) + (k & 7) * 2) = f2bf(acc[mi][ni][i]);
                }
        asm volatile("s_waitcnt vmcnt(0)" ::: "memory");
        __syncthreads();
        f32x16 acc2[2][2];
        acc2[0][0] = acc2[0][1] = acc2[1][0] = acc2[1][1] = zero16();
        {
            const int sw = (r >> 2) & 3;
            const int a_rd = (wm * 64 + r) * 64, b_rd = A_BYTES + (wn * 64 + r) * 64;
#pragma unroll
            for (int sl = 0; sl < 4; ++sl)
#pragma unroll
                for (int ks = 0; ks < 2; ++ks) {
                    const unsigned char* st = smem + sl * STAGE;
                    const int ko = ((2 * ks + h) ^ sw) * 16;
                    const bf16x8 a0 = *(const bf16x8*)(st + a_rd + ko), a1 = *(const bf16x8*)(st + a_rd + 32 * 64 + ko);
                    const bf16x8 b0 = *(const bf16x8*)(st + b_rd + ko), b1 = *(const bf16x8*)(st + b_rd + 32 * 64 + ko);
                    acc2[0][0] = MFMA32(a0, b0, acc2[0][0]); acc2[0][1] = MFMA32(a0, b1, acc2[0][1]);
                    acc2[1][0] = MFMA32(a1, b0, acc2[1][0]); acc2[1][1] = MFMA32(a1, b1, acc2[1][1]);
                }
        }
        __syncthreads();
        float* o = sc + (size_t)tm * 128 * D + tn * 128;
        EPI_FOR(2, acc2, { o[row * D + col] = v; })
    });
}
DI void phase7(const Params& p, unsigned char* smem) {}

DI float dot2u(unsigned a, unsigned b, float acc) { return __builtin_amdgcn_fdot2_f32_bf16(__builtin_bit_cast(bf16v2, a), __builtin_bit_cast(bf16v2, b), acc, false); }
DI float dot8(u32x4 a, u32x4 b, float acc) {
    const unsigned a0 = a.x, a1 = a.y, a2 = a.z, a3 = a.w, b0 = b.x, b1 = b.y, b2 = b.z, b3 = b.w;
    acc = dot2u(a0, b0, acc); acc = dot2u(a1, b1, acc); acc = dot2u(a2, b2, acc); acc = dot2u(a3, b3, acc);
    return acc;
}
DI float rdl(float v, int i) { return __int_as_float(__builtin_amdgcn_readlane(__float_as_int(v), i)); }
DI int f2key(float f) { const int k = __float_as_int(f); return k ^ ((k >> 31) & 0x7fffffff); }
DI int imax(int a, int b) { return a > b ? a : b; }
DI int imin(int a, int b) { return a < b ? a : b; }
DI void bitonic128(int& a, int& b, int lane) {
#pragma unroll
    for (int k = 2; k <= 128; k <<= 1) {
#pragma unroll
        for (int j = k >> 1; j > 0; j >>= 1) {
            if (j == 64) { const int na = imax(a, b), nb = imin(a, b); a = na; b = nb; }
            else {
                const int pa = shx(a, j), pb = shx(b, j);
                const bool lowj = (lane & j) == 0;
                bool kma, kmb;
                if (k < 64) { kma = ((lane & k) == 0) == lowj; kmb = kma; }
                else if (k == 64) { kma = lowj; kmb = !lowj; }
                else { kma = lowj; kmb = lowj; }
                a = kma ? imax(a, pa) : imin(a, pa);
                b = kmb ? imax(b, pb) : imin(b, pb);
            }
        }
    }
}
DI void bitonic64(int& a, int lane) {
#pragma unroll
    for (int k = 2; k <= 64; k <<= 1) {
#pragma unroll
        for (int j = k >> 1; j > 0; j >>= 1) {
            const int pa = shx(a, j);
            const bool lowj = (lane & j) == 0;
            const bool km = (k < 64) ? (((lane & k) == 0) == lowj) : lowj;
            a = km ? imax(a, pa) : imin(a, pa);
        }
    }
}
DI void phase8(const Params& p, unsigned char* smem) {
    unsigned char* ws = p.ws;
    const int tid = threadIdx.x, lane = tid & 63, wave = tid >> 6;
    const bf16_t* x1g = (const bf16_t*)(ws + WS_X1G);
    const float* scores = (const float*)(ws + WS_SCORES);
    const unsigned char* Ub = ws + WS_UB;
    const float* usc = (const float*)(ws + WS_USC);
    const unsigned char* Vb = ws + WS_VB;
    const float* vsc = (const float*)(ws + WS_VSC);
    int ca = 0, cb = lane, cvalid = 0;
#pragma unroll
    for (int aa = 0; aa < 16; ++aa) { const int cnt = 16 / (aa + 1); if (!cvalid) { if (cb < cnt) { ca = aa; cvalid = 1; } else cb -= cnt; } }
    if (!cvalid) { ca = 0; cb = 0; }

    int* wge = (int*)(smem + wave * 1024);
    float* wgg = (float*)(smem + wave * 1024 + 512);
    for (int t = blockIdx.x * 4 + wave; t < MT; t += gridDim.x * 4) {
        float* yrow = p.out + O_Y + (size_t)t * D;
        float ss = 0.f;
#pragma unroll
        for (int c = 0; c < 2; ++c)
#pragma unroll
            for (int q = 0; q < 4; ++q) { const f32x4 xv = *(const f32x4*)(yrow + c * 1024 + lane * 16 + 4 * q); ss += xv[0] * xv[0] + xv[1] * xv[1] + xv[2] * xv[2] + xv[3] * xv[3]; }
        const float rstd = rsqrtf(wave_sum(ss) * (1.0f / 2048.0f) + EPS);
        unsigned hq1[2][2], hq2[2][2];
        float hs1, hs2;
        {
            float hf[2][16];
            float am = 0.f;
#pragma unroll
            for (int c = 0; c < 2; ++c) {
                const u32x4 h0 = *(const u32x4*)(x1g + (size_t)t * D + c * 1024 + lane * 16), h1 = *(const u32x4*)(x1g + (size_t)t * D + c * 1024 + lane * 16 + 8);
                unpack8(h0, &hf[c][0]); unpack8(h1, &hf[c][8]);
#pragma unroll
                for (int j = 0; j < 16; ++j) am = fmaxf(am, fabsf(hf[c][j]));
            }
#pragma unroll
            for (int o = 32; o > 0; o >>= 1) am = fmaxf(am, shxf(am, o));
            hs1 = am > 0.f ? am * (1.0f / 7.0f) : 1.0f; hs2 = hs1 * (1.0f / 14.0f);
            const float i1 = 1.0f / hs1, i2 = 1.0f / hs2;
#pragma unroll
            for (int c = 0; c < 2; ++c)
#pragma unroll
                for (int d = 0; d < 2; ++d) {
                    unsigned a = 0, b = 0;
#pragma unroll
                    for (int j = 0; j < 8; ++j) {
                        const float x = hf[c][8 * d + j];
                        const float q1 = fminf(fmaxf(rintf(x * i1), -7.0f), 7.0f);
                        const float q2 = fminf(fmaxf(rintf((x - q1 * hs1) * i2), -7.0f), 7.0f);
                        a |= ((unsigned)(int)q1 & 0xFu) << (4 * j); b |= ((unsigned)(int)q2 & 0xFu) << (4 * j);
                    }
                    hq1[c][d] = a; hq2[c][d] = b;
                }
        }
#pragma unroll 1
        for (int hp = 0; hp < 4; ++hp) {
#pragma unroll
            for (int hh = 0; hh < 2; ++hh) {
                const float* sc = scores + (size_t)t * D + (hp * 2 + hh) * 256;
                const float v0a = sc[lane], v0b = sc[64 + lane], v1a = sc[128 + lane], v1b = sc[192 + lane];
                int k0a = (f2key(v0a) & ~127) | (127 - lane), k0b = (f2key(v0b) & ~127) | (63 - lane);
                int k1a = (f2key(v1a) & ~127) | (127 - lane), k1b = (f2key(v1b) & ~127) | (63 - lane);
                bitonic128(k0a, k0b, lane);
                bitonic128(k1a, k1b, lane);
                const int i0 = 127 - (k0a & 127), i1 = 127 - (k1a & 127);
                const float s0a = __shfl(v0a, i0 & 63), s0b = __shfl(v0b, i0 & 63), s1a = __shfl(v1a, i1 & 63), s1b = __shfl(v1b, i1 & 63);
                const float s0 = (i0 & 64) ? s0b : s0a, s1 = (i1 & 64) ? s1b : s1a;
                const float cval = __shfl(s0, ca) + __shfl(s1, cb);
                const int cexp = __shfl(i0, ca) * 128 + __shfl(i1, cb);
                int ck = cvalid ? ((f2key(cval) & ~63) | (63 - lane)) : (int)0x80000000;
                bitonic64(ck, lane);
                const int src = 63 - (ck & 63);
                const float tv = __shfl(cval, src);
                const int te = __shfl(cexp, src);
                const float mx = rdl(tv, 0);
                const float ew = lane < 16 ? __expf(rstd * (tv - mx)) : 0.f;
                float sum = ew;
                sum += shxf(sum, 8); sum += shxf(sum, 4); sum += shxf(sum, 2); sum += shxf(sum, 1);
                if (lane < 16) { wge[(hp * 2 + hh) * 16 + lane] = te; wgg[(hp * 2 + hh) * 16 + lane] = ew / sum; }
            }
        }
        f32x2 oacc2[2][8];
#pragma unroll
        for (int c = 0; c < 2; ++c)
#pragma unroll
            for (int j = 0; j < 8; ++j) oacc2[c][j] = (f32x2){0.f, 0.f};
#define PEER_LOAD(e_, ex_, gx_, us_, uu_, vv_)                                                                                   \
        {                                                                                                                   \
            _Pragma("unroll") for (int k = 0; k < 4; ++k) { ex_[k] = __builtin_amdgcn_readfirstlane(wge[(e_) + k]); gx_[k] = wgg[(e_) + k]; } \
            _Pragma("unroll") for (int k = 0; k < 4; ++k) { gx_[k] *= vsc[ex_[k]]; us_[k] = usc[ex_[k]]; }                \
            _Pragma("unroll") for (int k = 0; k < 4; ++k) _Pragma("unroll") for (int c = 0; c < 2; ++c)                     \
                uu_[k][c] = *(const u32x2*)(Ub + (size_t)ex_[k] * 1024 + c * 512 + lane * 8);                                \
            _Pragma("unroll") for (int k = 0; k < 4; ++k) _Pragma("unroll") for (int c = 0; c < 2; ++c)                     \
                vv_[k][c] = *(const u32x2*)(Vb + (size_t)ex_[k] * 1024 + c * 512 + lane * 8);                                \
        }
#define PEER_COMPUTE(ex_, gx_, us_, uu_, vv_)                                                                                    \
        {                                                                                                                   \
            float dd[4];                                                                                                    \
            _Pragma("unroll") for (int k = 0; k < 4; ++k) {                                                                 \
                int i1 = 0, i2 = 0;                                                                                         \
                _Pragma("unroll") for (int c = 0; c < 2; ++c) _Pragma("unroll") for (int q = 0; q < 2; ++q) {               \
                    const int w = (int)uu_[k][c][q];                                                                        \
                    i1 = __builtin_amdgcn_sdot8(w, (int)hq1[c][q], i1, false); i2 = __builtin_amdgcn_sdot8(w, (int)hq2[c][q], i2, false); \
                }                                                                                                           \
                dd[k] = (hs1 * (float)i1 + hs2 * (float)i2) * us_[k];                                                       \
                __builtin_amdgcn_sched_barrier(0);                    \
            }                                                                                                               \
            _Pragma("unroll") for (int o = 32; o > 0; o >>= 1) { _Pragma("unroll") for (int k = 0; k < 4; ++k) dd[k] += shxf(dd[k], o); } \
            _Pragma("unroll") for (int k = 0; k < 4; ++k) {                                                                 \
                const float aa = gx_[k] * gelu_fast(dd[k] * rstd);                                                   \
                const f32x2 ab = {aa, aa};                                                                                  \
                _Pragma("unroll") for (int c = 0; c < 2; ++c) _Pragma("unroll") for (int q = 0; q < 2; ++q) {               \
                    const unsigned w = vv_[k][c][q];                                                                        \
                    const f32x2 e0 = __builtin_amdgcn_cvt_scalef32_pk_f32_fp4(w, 1.0f, 0), e1 = __builtin_amdgcn_cvt_scalef32_pk_f32_fp4(w, 1.0f, 1); \
                    const f32x2 e2 = __builtin_amdgcn_cvt_scalef32_pk_f32_fp4(w, 1.0f, 2), e3 = __builtin_amdgcn_cvt_scalef32_pk_f32_fp4(w, 1.0f, 3); \
                    oacc2[c][4 * q] = ab * e0 + oacc2[c][4 * q]; oacc2[c][4 * q + 1] = ab * e1 + oacc2[c][4 * q + 1];       \
                    oacc2[c][4 * q + 2] = ab * e2 + oacc2[c][4 * q + 2]; oacc2[c][4 * q + 3] = ab * e3 + oacc2[c][4 * q + 3]; \
                }                                                                                                           \
                __builtin_amdgcn_sched_barrier(0);                                                                          \
            }                                                                                                               \
        }
        {
            int exA[4], exB[4]; float gxA[4], gxB[4], usA[4], usB[4];
            u32x2 uuA[4][2], uuB[4][2], vvA[4][2], vvB[4][2];
            PEER_LOAD(0, exA, gxA, usA, uuA, vvA)
#pragma unroll 1
            for (int e = 0; e < 128; e += 8) {
                PEER_LOAD(e + 4, exB, gxB, usB, uuB, vvB)
                PEER_COMPUTE(exA, gxA, usA, uuA, vvA)
                if (e + 8 < 128) PEER_LOAD(e + 8, exA, gxA, usA, uuA, vvA)
                PEER_COMPUTE(exB, gxB, usB, uuB, vvB)
            }
        }
#undef PEER_LOAD
#undef PEER_COMPUTE
        f32x4 xr[2][4];
#pragma unroll
        for (int c = 0; c < 2; ++c)
#pragma unroll
            for (int q = 0; q < 4; ++q) xr[c][q] = *(const f32x4*)(yrow + c * 1024 + lane * 16 + 4 * q);
#pragma unroll
        for (int c = 0; c < 2; ++c)
#pragma unroll
            for (int q = 0; q < 4; ++q) {
                f32x4 xv = xr[c][q];
                xv[0] += oacc2[c][2 * q][0]; xv[1] += oacc2[c][2 * q][1]; xv[2] += oacc2[c][2 * q + 1][0]; xv[3] += oacc2[c][2 * q + 1][1];
                *(f32x4*)(yrow + c * 1024 + lane * 16 + 4 * q) = xv;
            }
    }
}

#define XB_TMO      128
#define XB_XCNT(j)  (256  + 64 * (j))
#define XB_XSUB(j)  (1280 + 64 * (j))
#define XB_XGEN(j)  (2304 + 64 * (j))
#define XB_TOP      3328
#define XB_TOPGEN   3392
#define XCD_BAR_WORDS 3456
#define XB_SPIN_CAP (1u << 18)
DI unsigned xb_ld(unsigned* p) { return __hip_atomic_load(p, __ATOMIC_RELAXED, __HIP_MEMORY_SCOPE_AGENT); }
DI unsigned xb_add(unsigned* p, unsigned v) { return __hip_atomic_fetch_add(p, v, __ATOMIC_RELAXED, __HIP_MEMORY_SCOPE_AGENT); }
DI unsigned xb_xcc_id() { return (unsigned)__builtin_amdgcn_s_getreg((3 << 11) | 20) & 0xFu; }
#define XB_SPIN(cond, bar) do { unsigned _sp = 0; while (cond) { __builtin_amdgcn_s_sleep(1); \
    if ((++_sp & 255u) == 0u) { if (xb_ld(&(bar)[XB_TMO])) break; if (_sp > XB_SPIN_CAP) { atomicAdd(&(bar)[XB_TMO], 1u); break; } } } } while (0)
struct XcdBarrier { unsigned* bar; unsigned x; volatile LDS3 unsigned* st; };
DI XcdBarrier xcd_barrier_post(unsigned* bar, volatile LDS3 unsigned* st) {
    XcdBarrier b; b.bar = bar; b.x = xb_xcc_id(); b.st = st;
    if (threadIdx.x == 0) (void)xb_add(&bar[XB_XCNT(b.x)], 1u);
    return b;
}
DI void xcd_barrier_complete(unsigned* bar, unsigned x, unsigned& nloc, unsigned& nx) {
    const unsigned G = gridDim.x * gridDim.y * gridDim.z;
    unsigned sum, cnt, mine, sp = 0u;
    for (;;) {
        sum = 0u; cnt = 0u; mine = 0u;
#pragma unroll
        for (unsigned j = 0; j < 16; ++j) { const unsigned c = xb_ld(&bar[XB_XCNT(j)]); sum += c; cnt += (c > 0u) ? 1u : 0u; mine = (j == x) ? c : mine; }
        if (sum == G) break;
        __builtin_amdgcn_s_sleep(1);
        if ((++sp & 255u) == 0u) { if (xb_ld(&bar[XB_TMO])) break; if (sp > XB_SPIN_CAP) { atomicAdd(&bar[XB_TMO], 1u); break; } }
    }
    nloc = mine > 0u ? mine : 1u; nx = cnt > 0u ? cnt : 1u;
}
DI void xcd_barrier(const XcdBarrier& b) {
    asm volatile("s_waitcnt vmcnt(0)" ::: "memory");
    __syncthreads();
    if (threadIdx.x == 0) {
        unsigned* bar = b.bar;
        __builtin_amdgcn_s_waitcnt(0);
        unsigned nloc = b.st[0], nx = b.st[1];
        if (nloc == 0u) { xcd_barrier_complete(bar, b.x, nloc, nx); b.st[0] = nloc; b.st[1] = nx; }
        const unsigned old = xb_add(&bar[XB_XSUB(b.x)], 1u);
        const unsigned gen = old / nloc;
        if (old + 1u == (gen + 1u) * nloc) {
            __builtin_amdgcn_fence(__ATOMIC_RELEASE, "agent");
            asm volatile("s_waitcnt vmcnt(0)" ::: "memory");
            const unsigned og = xb_add(&bar[XB_TOP], 1u);
            const unsigned tg = og / nx;
            if (og + 1u == (tg + 1u) * nx) xb_add(&bar[XB_TOPGEN], 1u);
            else XB_SPIN(xb_ld(&bar[XB_TOPGEN]) == tg, bar);
            __builtin_amdgcn_fence(__ATOMIC_ACQUIRE, "agent");
            xb_add(&bar[XB_XGEN(b.x)], 1u);
            asm volatile("s_waitcnt vmcnt(0)" ::: "memory");
        } else {
            XB_SPIN(xb_ld(&bar[XB_XGEN(b.x)]) == gen, bar);
            __builtin_amdgcn_fence(__ATOMIC_ACQUIRE, "agent");
            asm volatile("s_waitcnt vmcnt(0)" ::: "memory");
        }
    }
    __syncthreads();
}

__global__ void __launch_bounds__(256, 2) mega(Params p, int ph_lo, int ph_hi, int coop) {
    extern __shared__ __attribute__((aligned(16))) unsigned char smem[];
    __shared__ uint4 xb_words;
    if (threadIdx.x == 0) xb_words = make_uint4(0u, 0u, 0u, 0u);
    __syncthreads();
    XcdBarrier xb;
    xb.bar = nullptr; xb.x = 0; xb.st = nullptr;
    if (coop) xb = xcd_barrier_post((unsigned*)(p.ws + WS_BAR), (volatile LDS3 unsigned*)&xb_words);
    if (coop == 2) cg::this_grid().sync();
#define RUN_PHASE(k, fn)                                              \
    if (ph_lo <= (k) && (k) < ph_hi) {                                  \
        fn(p, smem);                                                    \
        if (coop && (k) + 1 < ph_hi) xcd_barrier(xb);                   \
    }
    RUN_PHASE(0, phase0)
    RUN_PHASE(1, phase1)
    RUN_PHASE(2, phase2)
    RUN_PHASE(3, phase3)
    RUN_PHASE(4, phase4)
    RUN_PHASE(5, phase5)
    RUN_PHASE(6, phase6)
    RUN_PHASE(8, phase8)
}

#ifndef N_LAUNCH_MODE
#define N_LAUNCH_MODE 1
#endif

extern "C" void kernel_launch(void* const* d_in, const int* in_sizes, int n_in, void* d_out, int out_size, void* d_ws, size_t ws_size, hipStream_t stream) {
    static int grid = 0;
    if (grid == 0) {
        int dev = 0, cus = 0, per_cu = 0;
        hipGetDevice(&dev);
        hipDeviceGetAttribute(&cus, hipDeviceAttributeMultiprocessorCount, dev);
        hipFuncSetAttribute((const void*)mega, hipFuncAttributeMaxDynamicSharedMemorySize, LDS_BYTES);
        hipOccupancyMaxActiveBlocksPerMultiprocessor(&per_cu, (const void*)mega, 256, LDS_BYTES);
        if (per_cu < 1) per_cu = 1;
        if (per_cu > 2) per_cu = 2;
        grid = cus * per_cu;
        if (n_in != 32 || ws_size < WS_END) { fprintf(stderr, "kernel_launch: unexpected n_in %d / ws_size %zu (need %zu)\n", n_in, ws_size, (size_t)WS_END); grid = -1; }
    }
    if (grid < 0) return;
    Params p{};
    for (int i = 0; i < 32; ++i) p.in[i] = (const float*)d_in[i];
    p.out = (float*)d_out;
    p.ws = (unsigned char*)d_ws;
    hipMemsetAsync((char*)d_ws + WS_CTL, 0, 32768, stream);
#if N_LAUNCH_MODE == 1
    int lo = 0, hi = 9, coop = 1;
    void* args[] = {&p, &lo, &hi, &coop};
    hipError_t e = hipLaunchCooperativeKernel((const void*)mega, dim3(grid), dim3(256), args, LDS_BYTES, stream);
    if (e != hipSuccess) fprintf(stderr, "cooperative launch failed: %s (grid %d)\n", hipGetErrorString(e), grid);
#else
    for (int ph = 0; ph < 9; ++ph) hipLaunchKernelGGL(mega, dim3(grid), dim3(256), LDS_BYTES, stream, p, ph, ph + 1, 0);
#endif
}
```

```cpp
#include <hip/hip_runtime.h>
#include <hip/hip_cooperative_groups.h>
#include <cstdint>
#include <cstdio>
namespace cg = cooperative_groups;

#define DI __device__ __forceinline__
typedef unsigned short bf16_t;
typedef short bf16x8 __attribute__((ext_vector_type(8)));
typedef short s16x4 __attribute__((ext_vector_type(4)));
typedef float f32x16 __attribute__((ext_vector_type(16)));
typedef float f32x4 __attribute__((ext_vector_type(4)));
typedef float f32x2 __attribute__((ext_vector_type(2)));
typedef unsigned u32x4 __attribute__((ext_vector_type(4)));
typedef unsigned u32x2 __attribute__((ext_vector_type(2)));
typedef __bf16 bf16v2 __attribute__((ext_vector_type(2)));
#define LDS3 __attribute__((address_space(3)))

constexpr int D = 2048, NP = 8192, NS = 512, MT = 8704, INW = 10752;
constexpr int OFF_Q = 0, OFF_K = 1024, OFF_V = 2048, OFF_U = 3072, OFF_VC = 3584, OFF_QM = 4096, OFF_G = 4608;
constexpr float EPS = 1e-6f;
constexpr float LOG2E = 1.4426950408889634f;
constexpr size_t O_Y = 0, O_KP = 17825792, O_VP = 26214400, O_MKP = 34603008, O_MVP = 35127296, O_KS = 35651584, O_VS = 36175872, O_CVS = 36700160;
constexpr size_t WS_CTL = 0;
constexpr size_t WS_BAR = 4096;
constexpr size_t WS_UB = 32768;
constexpr size_t WS_VB = WS_UB + 67108864;
constexpr size_t WS_P = WS_VB + 67108864;
constexpr size_t WS_WINT = WS_P + 187170816;
constexpr size_t WS_HB = WS_WINT + 44040192;
constexpr size_t WS_WMEMT = WS_HB + 35651584;
constexpr size_t WS_WBT = WS_WMEMT + 4194304;
constexpr size_t WS_WOT = WS_WBT + 8388608;
constexpr size_t WS_WQT = WS_WOT + 8388608;
constexpr size_t WS_MEMHB = WS_WQT + 8388608;
constexpr size_t WS_SKB = WS_MEMHB + 4194304;
constexpr size_t WS_KS = WS_SKB + 524288;
constexpr size_t WS_VS = WS_KS + 17825792;
constexpr size_t WS_MEMKV = WS_VS + 17825792;
constexpr size_t WS_MEMKB = WS_MEMKV + 4194304;
constexpr size_t WS_MEMVB = WS_MEMKB + 1048576;
constexpr size_t WS_CMK = WS_MEMVB + 1048576;
constexpr size_t WS_CMV = WS_CMK + 2097152;
constexpr size_t WS_VSC = WS_CMV + 2097152;
constexpr size_t WS_USC = WS_VSC + 65536;
constexpr size_t WS_ROPE = WS_USC + 65536;
constexpr size_t WS_END = WS_ROPE + 2112 * 8 * 8;
constexpr size_t WS_MIXIN = WS_WINT;
constexpr size_t WS_MERGED = WS_HB;
constexpr size_t WS_X1G = WS_WINT;
constexpr size_t WS_PEERQ = WS_HB;
constexpr size_t WS_SCORES = WS_P;

constexpr int LDS_BYTES = 73728;

struct Params {
    const float* in[32];
    float* out;
    unsigned char* ws;
};
enum { I_XP = 0, I_XS, I_MEMP, I_CDK, I_CDV, I_CMK, I_CMV, I_NMIXG, I_WIN, I_BGATE, I_QNG, I_KNG, I_LQ1, I_LK1, I_LQ2, I_LK2, I_OUTG,
       I_CMLNG, I_CMLNB, I_CMWS, I_CMBS, I_NMEMG, I_WMEMKV, I_MQNG, I_MKNG, I_WBR, I_WOUT, I_NFFNG, I_PWQ, I_PSK, I_PU, I_PV };

DI unsigned pk2(float lo, float hi) { f32x2 f = {lo, hi}; bf16v2 b = __builtin_convertvector(f, bf16v2); return __builtin_bit_cast(unsigned, b); }
DI bf16_t f2bf(float x) { return (bf16_t)(pk2(x, 0.f) & 0xffffu); }
DI float bflo(unsigned u) { return __uint_as_float(u << 16); }
DI float bfhi(unsigned u) { return __uint_as_float(u & 0xffff0000u); }
DI float bf2f(bf16_t b) { return __uint_as_float(((unsigned)b) << 16); }
DI void unpack8(u32x4 v, float* f) { f[0] = bflo(v.x); f[1] = bfhi(v.x); f[2] = bflo(v.y); f[3] = bfhi(v.y); f[4] = bflo(v.z); f[5] = bfhi(v.z); f[6] = bflo(v.w); f[7] = bfhi(v.w); }
DI u32x4 pack8(const float* f) { u32x4 r; r.x = pk2(f[0], f[1]); r.y = pk2(f[2], f[3]); r.z = pk2(f[4], f[5]); r.w = pk2(f[6], f[7]); return r; }
DI int shx(int v, int j) {
    switch (j) {
        case 1: return __builtin_amdgcn_update_dpp(0, v, 0xB1, 0xF, 0xF, true);
        case 2: return __builtin_amdgcn_update_dpp(0, v, 0x4E, 0xF, 0xF, true);
        case 4: return __builtin_amdgcn_update_dpp(0, __builtin_amdgcn_update_dpp(0, v, 0x141, 0xF, 0xF, true), 0x1B, 0xF, 0xF, true);
        case 8: return __builtin_amdgcn_update_dpp(0, v, 0x128, 0xF, 0xF, true);
        case 16: { const u32x2 r = __builtin_amdgcn_permlane16_swap((unsigned)v, (unsigned)v, false, false); return (threadIdx.x & 16) ? (int)r[0] : (int)r[1]; }
        default: { const u32x2 r = __builtin_amdgcn_permlane32_swap((unsigned)v, (unsigned)v, false, false); return (threadIdx.x & 32) ? (int)r[0] : (int)r[1]; }
    }
}
DI float shxf(float v, int j) { return __int_as_float(shx(__float_as_int(v), j)); }
DI float wave_sum(float v) {
#pragma unroll
    for (int o = 32; o > 0; o >>= 1) v += shxf(v, o);
    return v;
}
DI int opaque_tid() { int t = threadIdx.x; asm volatile("" : "+v"(t)); return t; }
DI int crow(int i, int h) { return (i & 3) + 8 * (i >> 2) + 4 * h; }
DI float gelu_exact(float x) { return 0.5f * x * (1.0f + erff(x * 0.70710678118654752f)); }
DI float gelu_fast(float v) {
    const float av = fabsf(v), t = __builtin_amdgcn_rcpf(av * 0.2316418882f + 1.0f);
    float q = t * 0.5307027145f + (-0.7265760135f); q = q * t + 0.7107068705f; q = q * t + (-0.142248368f); q = q * t + 0.127414796f; q = q * t;
    const float e = __builtin_amdgcn_exp2f((v * v) * (-0.72134752044f));
    const float m = v * (q * e);
    return v < 0.f ? m : v - m;
}
#define MFMA32(a, b, c) __builtin_amdgcn_mfma_f32_32x32x16_bf16((a), (b), (c), 0, 0, 0)
DI f32x16 zero16() { f32x16 z; for (int i = 0; i < 16; ++i) z[i] = 0.f; return z; }
DI bf16x8 tr_pair(const unsigned char* lo, const unsigned char* hi) {
    s16x4 a = __builtin_amdgcn_ds_read_tr16_b64_v4i16((LDS3 s16x4*)lo);
    s16x4 b = __builtin_amdgcn_ds_read_tr16_b64_v4i16((LDS3 s16x4*)hi);
    return __builtin_shufflevector(a, b, 0, 1, 2, 3, 4, 5, 6, 7);
}

#define SGPR(x) __builtin_amdgcn_readfirstlane(x)
template <class F> DI void for_tiles(int TM, int TN, F f) {
    const int T = TM * TN, G = gridDim.x, bid = blockIdx.x;
    const int nx = (G % 8 == 0) ? 8 : 1;
    const int xcd = SGPR(bid % nx), idx = SGPR(bid / nx), per = SGPR(G / nx);
    const int chunk = SGPR((T + nx - 1) / nx);
    for (int v = idx; v < chunk; v += per) {
        const int id = xcd * chunk + v;
        if (id >= T) break;
        const int gsize = 8 * TN, g = SGPR(id / gsize), rem = id - g * gsize;
        const int mrows = (TM - 8 * g) < 8 ? (TM - 8 * g) : 8;
        const int tn = SGPR(rem / mrows), tm = 8 * g + (rem - tn * mrows);
        f(tm, tn);
    }
}

#define GLB1 __attribute__((address_space(1)))
template <int N> DI void wait_vm() {
    if constexpr (N == 0) asm volatile("s_waitcnt vmcnt(0)" ::: "memory");
    else if constexpr (N == 3) asm volatile("s_waitcnt vmcnt(3)" ::: "memory");
    else if constexpr (N == 4) asm volatile("s_waitcnt vmcnt(4)" ::: "memory");
    else if constexpr (N == 6) asm volatile("s_waitcnt vmcnt(6)" ::: "memory");
    else if constexpr (N == 8) asm volatile("s_waitcnt vmcnt(8)" ::: "memory");
    else if constexpr (N == 12) asm volatile("s_waitcnt vmcnt(12)" ::: "memory");
    else if constexpr (N == 16) asm volatile("s_waitcnt vmcnt(16)" ::: "memory");
    else static_assert(N == 0, "add the count");
}
template <int MI, int NST>
DI void gemm_kloop(f32x16 (&acc)[MI][2], const bf16_t* __restrict__ Ag, int lda, const bf16_t* __restrict__ Bg, int ldb, int nk  , unsigned char* smem) {
    constexpr int AROWS = 64 * MI, A_BYTES = AROWS * 64, STAGE = A_BYTES + 128 * 64, AL = MI  , BL = 2, LPW = AL + BL;
    static_assert(NST >= 3 && NST * STAGE <= 73728, "ring does not fit");
    const int tid = opaque_tid(), lane = tid & 63, wave = tid >> 6, wm = wave >> 1, wn = wave & 1, r = lane & 31, h = lane >> 5;
    const int frow = lane >> 2, fslot = lane & 3;
    const int kcs = (fslot ^ ((frow >> 2) & 3)) * 8;
    const int aoff0 = (wave * AL * 16 + frow) * lda + kcs, boff0 = (wave * BL * 16 + frow) * ldb + kcs;
    unsigned char* afill = smem + wave * AL * 1024;
    unsigned char* bfill = smem + A_BYTES + wave * BL * 1024;
#define GEMM_FILL(slot_, kt_)                                                                                                        \
    {                                                                                                                                \
        _Pragma("unroll") for (int i = 0; i < AL; ++i)                                                                               \
            __builtin_amdgcn_global_load_lds((GLB1 const void*)(Ag + (size_t)(i * 16) * lda + (kt_) * 32 + aoff0), (LDS3 void*)(afill + (slot_) * STAGE + i * 1024), 16, 0, 0); \
        _Pragma("unroll") for (int i = 0; i < BL; ++i)                                                                               \
            __builtin_amdgcn_global_load_lds((GLB1 const void*)(Bg + (size_t)(i * 16) * ldb + (kt_) * 32 + boff0), (LDS3 void*)(bfill + (slot_) * STAGE + i * 1024), 16, 0, 0); \
    }
#pragma unroll
    for (int t = 0; t < NST - 1; ++t) GEMM_FILL(t, t)
    const int sw = (r >> 2) & 3;
    const int k0off = ((0 + h) ^ sw) * 16, k1off = ((2 + h) ^ sw) * 16;
    const int a_rd = (wm * 32 * MI + r) * 64;
    const int b_rd = A_BYTES + (wn * 64 + r) * 64;
    int slot = 0;
    for (int kt = 0; kt < nk; ++kt) {
        const int rem = nk - 1 - kt;
        if (rem >= NST - 2) wait_vm<(NST - 2) * LPW>();
        else if (NST >= 4 && rem == 2) wait_vm<2 * LPW>();
        else if (rem == 1) wait_vm<LPW>();
        else wait_vm<0>();
        __builtin_amdgcn_s_barrier();
        asm volatile("" ::: "memory");
        if (kt + NST - 1 < nk) { const int fs = slot == 0 ? NST - 1 : slot - 1; GEMM_FILL(fs, kt + NST - 1) }
        const unsigned char* st = smem + slot * STAGE;
#pragma unroll
        for (int ks = 0; ks < 2; ++ks) {
            const int ko = ks == 0 ? k0off : k1off;
            bf16x8 b[2];
#pragma unroll
            for (int ni = 0; ni < 2; ++ni) b[ni] = *(const bf16x8*)(st + b_rd + ni * 32 * 64 + ko);
            constexpr int MS = MI >= 2 ? 2 : 1;
#pragma unroll
            for (int m0 = 0; m0 < MI; m0 += MS) {
                bf16x8 a[MS];
#pragma unroll
                for (int mi = 0; mi < MS; ++mi) a[mi] = *(const bf16x8*)(st + a_rd + (m0 + mi) * 32 * 64 + ko);
                __builtin_amdgcn_s_setprio(1);
#pragma unroll
                for (int mi = 0; mi < MS; ++mi)
#pragma unroll
                    for (int ni = 0; ni < 2; ++ni) acc[m0 + mi][ni] = MFMA32(a[mi], b[ni], acc[m0 + mi][ni]);
                __builtin_amdgcn_s_setprio(0);
            }
        }
        slot = slot + 1 == NST ? 0 : slot + 1;
    }
    __syncthreads();
#undef GEMM_FILL
}
#define EPI_FOR(MI_, acc_, BODY)                                                                             \
    {                                                                                                        \
        const int tid_ = opaque_tid(), lane_ = tid_ & 63, wave_ = tid_ >> 6, r_ = lane_ & 31, h_ = lane_ >> 5; \
        _Pragma("unroll") for (int mi_ = 0; mi_ < (MI_); ++mi_) _Pragma("unroll") for (int ni_ = 0; ni_ < 2; ++ni_) { \
            _Pragma("unroll") for (int i_ = 0; i_ < 16; ++i_) {                                              \
            const int row = (wave_ >> 1) * 32 * (MI_) + mi_ * 32 + crow(i_, h_);                             \
            const int col = (wave_ & 1) * 64 + ni_ * 32 + r_;                                                \
            const float v = acc_[mi_][ni_][i_];                                                              \
            BODY                                                                                             \
            if ((i_ & 3) == 3) asm volatile("" ::: "memory");     \
            }                                                                                                \
        }                                                                                                    \
    }

#define EPI_STORE_BF16(MI_, acc_, optr_, ld_)                                                                 \
    {                                                                                                        \
        const int tid_ = opaque_tid(), lane_ = tid_ & 63, wave_ = tid_ >> 6, r_ = lane_ & 31, h_ = lane_ >> 5; \
        const bool odd_ = (r_ & 1) != 0;                                                                     \
        _Pragma("unroll") for (int mi_ = 0; mi_ < (MI_); ++mi_) _Pragma("unroll") for (int ni_ = 0; ni_ < 2; ++ni_) \
            _Pragma("unroll") for (int i_ = 0; i_ < 16; i_ += 2) {                                           \
            const float a0_ = acc_[mi_][ni_][i_], a1_ = acc_[mi_][ni_][i_ + 1];                              \
            const float recv_ = shxf(odd_ ? a0_ : a1_, 1);                                                   \
            const int row_ = (wave_ >> 1) * 32 * (MI_) + mi_ * 32 + crow(i_ + (odd_ ? 1 : 0), h_);           \
            const int col_ = (wave_ & 1) * 64 + ni_ * 32 + (r_ & ~1);                                        \
            *(unsigned*)((optr_) + row_ * (ld_) + col_) = odd_ ? pk2(recv_, a1_) : pk2(a0_, recv_);          \
        }                                                                                                    \
    }

DI void rmsnorm_row_to_bf16(const float* x, const float* g, bf16_t* o, int lane) {
    f32x4 v[8], gq[8];
    float ss = 0.f;
#pragma unroll
    for (int c = 0; c < 8; ++c) { v[c] = *(const f32x4*)(x + c * 256 + lane * 4); gq[c] = *(const f32x4*)(g + c * 256 + lane * 4); }
#pragma unroll
    for (int c = 0; c < 8; ++c) ss += v[c][0] * v[c][0] + v[c][1] * v[c][1] + v[c][2] * v[c][2] + v[c][3] * v[c][3];
    ss = wave_sum(ss);
    const float rstd = rsqrtf(ss * (1.0f / 2048.0f) + EPS);
#pragma unroll
    for (int c = 0; c < 8; ++c) {
        const f32x4 gg = gq[c];
        u32x2 w; w.x = pk2(v[c][0] * rstd * gg[0], v[c][1] * rstd * gg[1]); w.y = pk2(v[c][2] * rstd * gg[2], v[c][3] * rstd * gg[3]);
        *(u32x2*)(o + c * 256 + lane * 4) = w;
    }
}
DI void transpose_tile(const float* W, int N, bf16_t* WT, int kt, int nt, unsigned char* smem) {
    float* tile = (float*)smem;
    const int tid = threadIdx.x;
#pragma unroll
    for (int i = 0; i < 4; ++i) {
        const int k = (tid >> 4) + 16 * i, n4 = (tid & 15) * 4;
        const f32x4 v = *(const f32x4*)(W + (size_t)(kt * 64 + k) * N + nt * 64 + n4);
        tile[k * 65 + n4 + 0] = v[0]; tile[k * 65 + n4 + 1] = v[1]; tile[k * 65 + n4 + 2] = v[2]; tile[k * 65 + n4 + 3] = v[3];
    }
    __syncthreads();
#pragma unroll
    for (int i = 0; i < 2; ++i) {
        const int n = (tid >> 3) + 32 * i, kc = (tid & 7) * 8;
        float f[8];
#pragma unroll
        for (int j = 0; j < 8; ++j) f[j] = tile[(kc + j) * 65 + n];
        *(u32x4*)(WT + (size_t)(nt * 64 + n) * 2048 + kt * 64 + kc) = pack8(f);
    }
    __syncthreads();
}
DI void convert_job(const float* src, bf16_t* dst, int job) {
    const int tid = threadIdx.x;
    f32x4 a[4], b[4];
#pragma unroll
    for (int i = 0; i < 4; ++i) { const size_t idx = (size_t)job * 8192 + i * 2048 + tid * 8; a[i] = *(const f32x4*)(src + idx); b[i] = *(const f32x4*)(src + idx + 4); }
#pragma unroll
    for (int i = 0; i < 4; ++i) {
        const size_t idx = (size_t)job * 8192 + i * 2048 + tid * 8;
        u32x4 w; w.x = pk2(a[i][0], a[i][1]); w.y = pk2(a[i][2], a[i][3]); w.z = pk2(b[i][0], b[i][1]); w.w = pk2(b[i][2], b[i][3]);
        *(u32x4*)(dst + idx) = w;
    }
}
DI void convert8_job(const float* src, unsigned char* dst, int job, float scale) {
    const int tid = threadIdx.x;
#pragma unroll
    for (int i = 0; i < 2; ++i) {
        const size_t idx = (size_t)job * 8192 + i * 4096 + tid * 16;
        u32x4 w;
#pragma unroll
        for (int q = 0; q < 4; ++q) {
            const f32x4 a = *(const f32x4*)(src + idx + 4 * q);
            int t = 0;
            t = __builtin_amdgcn_cvt_pk_fp8_f32(a[0] * scale, a[1] * scale, t, false);
            t = __builtin_amdgcn_cvt_pk_fp8_f32(a[2] * scale, a[3] * scale, t, true);
            w[q] = (unsigned)t;
        }
        *(u32x4*)(dst + idx) = w;
    }
}
DI void convert4_rows(const float* src, unsigned char* dst, float* rowscale, int job) {
    const int tid = threadIdx.x, lane = tid & 63, wave = tid >> 6;
    const int row = job * 4 + wave;
    const float* sp = src + (size_t)row * D;
    f32x4 v[2][4];
    float am = 0.f;
#pragma unroll
    for (int c = 0; c < 2; ++c)
#pragma unroll
        for (int q = 0; q < 4; ++q) {
            v[c][q] = *(const f32x4*)(sp + c * 1024 + lane * 16 + 4 * q);
            am = fmaxf(am, fmaxf(fmaxf(fabsf(v[c][q][0]), fabsf(v[c][q][1])), fmaxf(fabsf(v[c][q][2]), fabsf(v[c][q][3]))));
        }
#pragma unroll
    for (int o = 32; o > 0; o >>= 1) am = fmaxf(am, shxf(am, o));
    const float sc = am > 0.f ? am * (1.0f / 6.0f) : 1.0f, inv = 1.0f / sc;
    if (lane == 0) rowscale[row] = sc;
#pragma unroll
    for (int c = 0; c < 2; ++c) {
        u32x2 w;
#pragma unroll
        for (int d = 0; d < 2; ++d) {
            unsigned t = 0;
            const f32x4 a = v[c][2 * d], b = v[c][2 * d + 1];
            t = __builtin_amdgcn_cvt_scalef32_pk_fp4_f32(t, a[0] * inv, a[1] * inv, 1.0f, 0);
            t = __builtin_amdgcn_cvt_scalef32_pk_fp4_f32(t, a[2] * inv, a[3] * inv, 1.0f, 1);
            t = __builtin_amdgcn_cvt_scalef32_pk_fp4_f32(t, b[0] * inv, b[1] * inv, 1.0f, 2);
            t = __builtin_amdgcn_cvt_scalef32_pk_fp4_f32(t, b[2] * inv, b[3] * inv, 1.0f, 3);
            w[d] = t;
        }
        *(u32x2*)(dst + (size_t)row * 1024 + c * 512 + lane * 8) = w;
    }
}
DI void convert_i4_rows(const float* src, unsigned char* dst, float* rowscale, int job) {
    const int tid = threadIdx.x, lane = tid & 63, wave = tid >> 6;
    const int row = job * 4 + wave;
    const float* sp = src + (size_t)row * D;
    f32x4 v[2][4];
    float am = 0.f;
#pragma unroll
    for (int c = 0; c < 2; ++c)
#pragma unroll
        for (int q = 0; q < 4; ++q) {
            v[c][q] = *(const f32x4*)(sp + c * 1024 + lane * 16 + 4 * q);
            am = fmaxf(am, fmaxf(fmaxf(fabsf(v[c][q][0]), fabsf(v[c][q][1])), fmaxf(fabsf(v[c][q][2]), fabsf(v[c][q][3]))));
        }
#pragma unroll
    for (int o = 32; o > 0; o >>= 1) am = fmaxf(am, shxf(am, o));
    const float sc = am > 0.f ? am * (1.0f / 7.0f) : 1.0f, inv = 1.0f / sc;
    if (lane == 0) rowscale[row] = sc;
#pragma unroll
    for (int c = 0; c < 2; ++c) {
        u32x2 w;
#pragma unroll
        for (int d = 0; d < 2; ++d) {
            unsigned t = 0;
#pragma unroll
            for (int j = 0; j < 8; ++j) {
                const float x = v[c][2 * d + (j >> 2)][j & 3] * inv;
                const int qi = (int)fminf(fmaxf(rintf(x), -7.0f), 7.0f);
                t |= ((unsigned)qi & 0xFu) << (4 * j);
            }
            w[d] = t;
        }
        *(u32x2*)(dst + (size_t)row * 1024 + c * 512 + lane * 8) = w;
    }
}
DI void phase0(const Params& p, unsigned char* smem) {
    const int tid = threadIdx.x, lane = tid & 63, wave = tid >> 6;
    unsigned char* ws = p.ws;
    constexpr int J_NORM = 2432, J_TR = 8960, J_CV = 10528 - 8192, J_ROPE = 66, J_ALL = J_NORM + J_TR + J_CV + J_ROPE;
    for (int job = blockIdx.x; job < J_ALL; job += gridDim.x) {
        if (job >= J_NORM + J_TR + J_CV) {
            const int idx = (job - (J_NORM + J_TR + J_CV)) * 256 + tid;
            const int pos = idx >> 3, i = idx & 7;
            const float inv = exp2f(-(float)i * (18.931568569324174f / 8.0f));
            float sn, cs; sincosf((float)pos * inv, &sn, &cs);
            ((f32x2*)(ws + WS_ROPE))[idx] = (f32x2){cs, sn};
            continue;
        }
        if (job < J_NORM) {
            const int row = job * 4 + wave;
            if (row < MT) {
                const float* x = row < NP ? p.in[I_XP] + (size_t)row * D : p.in[I_XS] + (size_t)(row - NP) * D;
                rmsnorm_row_to_bf16(x, p.in[I_NMIXG], (bf16_t*)(ws + WS_HB) + (size_t)row * D, lane);
            } else {
                const int mr = row - MT;
                rmsnorm_row_to_bf16(p.in[I_MEMP] + (size_t)mr * D, p.in[I_NMEMG], (bf16_t*)(ws + WS_MEMHB) + (size_t)mr * D, lane);
            }
        } else if (job < J_NORM + J_TR) {
            int j = job - J_NORM;
            if (j < 5376) { transpose_tile(p.in[I_WIN], INW, (bf16_t*)(ws + WS_WINT), j / 168, j % 168, smem); }
            else if (j < 5376 + 512) { j -= 5376; transpose_tile(p.in[I_WMEMKV], 1024, (bf16_t*)(ws + WS_WMEMT), j / 16, j % 16, smem); }
            else if (j < 5888 + 1024) { j -= 5888; transpose_tile(p.in[I_WBR], 2048, (bf16_t*)(ws + WS_WBT), j / 32, j % 32, smem); }
            else if (j < 6912 + 1024) { j -= 6912; transpose_tile(p.in[I_WOUT], 2048, (bf16_t*)(ws + WS_WOT), j / 32, j % 32, smem); }
            else { j -= 7936; transpose_tile(p.in[I_PWQ], 2048, (bf16_t*)(ws + WS_WQT), j / 32, j % 32, smem); }
        } else {
            int j = job - J_NORM - J_TR + 8192;
            if (j < 8192) {   }
            else if (j < 9216) { j -= 8192; const int b = j >> 7, jj = j & 127; convert_job(p.in[I_CDK] + (size_t)b * 1048576, (bf16_t*)(ws + WS_KS) + (size_t)b * 1088 * 1024, jj); }
            else if (j < 10240) { j -= 9216; const int b = j >> 7, jj = j & 127; convert_job(p.in[I_CDV] + (size_t)b * 1048576, (bf16_t*)(ws + WS_VS) + (size_t)b * 1088 * 1024, jj); }
            else if (j < 10368) convert_job(p.in[I_CMK], (bf16_t*)(ws + WS_CMK), j - 10240);
            else if (j < 10496) convert_job(p.in[I_CMV], (bf16_t*)(ws + WS_CMV), j - 10368);
            else convert_job(p.in[I_PSK], (bf16_t*)(ws + WS_SKB), j - 10496);
        }
    }
}

DI void phase1(const Params& p, unsigned char* smem) {
    unsigned char* ws = p.ws;
    const bf16_t* Hb = (const bf16_t*)(ws + WS_HB);
    const bf16_t* WinT = (const bf16_t*)(ws + WS_WINT);
    bf16_t* P = (bf16_t*)(ws + WS_P);
    for_tiles(34, 84, [&](int tm, int tn) {
        f32x16 acc[4][2];
#pragma unroll
        for (int mi = 0; mi < 4; ++mi) acc[mi][0] = acc[mi][1] = zero16();
        gemm_kloop<4, 3>(acc, Hb + (size_t)tm * 256 * D, D, WinT + (size_t)tn * 128 * D, D, 64, smem);
        bf16_t* o = P + (size_t)tm * 256 * INW + tn * 128;
        EPI_STORE_BF16(4, acc, o, INW)
    });
    const bf16_t* MemHb = (const bf16_t*)(ws + WS_MEMHB);
    const bf16_t* WmemT = (const bf16_t*)(ws + WS_WMEMT);
    float* MemKV = (float*)(ws + WS_MEMKV);
    for (int t = gridDim.x - 1 - blockIdx.x; t < 32; t += gridDim.x) {
        const int tm = t >> 3, tn = t & 7;
        f32x16 acc[4][2];
#pragma unroll
        for (int mi = 0; mi < 4; ++mi) acc[mi][0] = acc[mi][1] = zero16();
        gemm_kloop<4, 3>(acc, MemHb + (size_t)tm * 256 * D, D, WmemT + (size_t)tn * 128 * D, D, 64, smem);
        float* o = MemKV + (size_t)tm * 256 * 1024 + tn * 128;
        EPI_FOR(4, acc, { o[row * 1024 + col] = v; })
    }
}

DI void qk_norm_rope(float* v, f32x4 g0, f32x4 g1, int gl, const float* cs, const float* sn, float scale) {
    float ss = 0.f;
#pragma unroll
    for (int i = 0; i < 8; ++i) ss += v[i] * v[i];
    ss += shxf(ss, 1); ss += shxf(ss, 2); ss += shxf(ss, 4);
    const float rstd = rsqrtf(ss * (1.0f / 64.0f) + EPS);
    float y[8];
#pragma unroll
    for (int i = 0; i < 4; ++i) { y[i] = v[i] * rstd * g0[i]; y[4 + i] = v[4 + i] * rstd * g1[i]; }
#pragma unroll
    for (int i = 0; i < 8; ++i) {
        const float pr = shxf(y[i], 1);
        float o = y[i];
        if (gl == 0) o = y[i] * cs[i] - pr * sn[i];
        else if (gl == 1) o = y[i] * cs[i] + pr * sn[i];
        v[i] = o * scale;
    }
}
DI void phase2(const Params& p, unsigned char* smem) {
    const int tid = threadIdx.x, lane = tid & 63, wave = tid >> 6;
    unsigned char* ws = p.ws;
    bf16_t* P = (bf16_t*)(ws + WS_P);
    float* out = p.out;
    constexpr int J_TOK = 2176, J_MEM = 256;
    for (int job = blockIdx.x; job < J_TOK + J_MEM; job += gridDim.x) {
        if (job < J_TOK) {
            const int row = job * 4 + wave;
            const bool samp = row >= NP;
            const int rs = row - NP;
            const int pos = samp ? 1024 + (rs & 63) : (row & 2047);
            bf16_t* pr = P + (size_t)row * INW;
            u32x4 in[9];
#pragma unroll
            for (int c = 0; c < 9; ++c) in[c] = *(const u32x4*)(pr + c * 512 + lane * 8);
            float cs[8], sn[8];
            {
                const f32x4* rt = (const f32x4*)(ws + WS_ROPE) + pos * 4;
#pragma unroll
                for (int i = 0; i < 4; ++i) { const f32x4 v = rt[i]; cs[2 * i] = v[0]; sn[2 * i] = v[1]; cs[2 * i + 1] = v[2]; sn[2 * i + 1] = v[3]; }
            }
            const int gl = lane & 7;
            const f32x4 qg0 = *(const f32x4*)(p.in[I_QNG] + gl * 8), qg1 = *(const f32x4*)(p.in[I_QNG] + gl * 8 + 4);
            const f32x4 kg0 = *(const f32x4*)(p.in[I_KNG] + gl * 8), kg1 = *(const f32x4*)(p.in[I_KNG] + gl * 8 + 4);
            const f32x4 lg0 = *(const f32x4*)(p.in[I_CMLNG] + lane * 8), lg1 = *(const f32x4*)(p.in[I_CMLNG] + lane * 8 + 4);
            const f32x4 lb0 = *(const f32x4*)(p.in[I_CMLNB] + lane * 8), lb1 = *(const f32x4*)(p.in[I_CMLNB] + lane * 8 + 4);
            const f32x4 mg0 = *(const f32x4*)(p.in[I_MQNG] + (lane & 15) * 8), mg1 = *(const f32x4*)(p.in[I_MQNG] + (lane & 15) * 8 + 4);
#pragma unroll
            for (int ps = 0; ps < 2; ++ps) {
                float f[8]; unpack8(in[ps], f);
                qk_norm_rope(f, qg0, qg1, gl, cs, sn, 0.125f * LOG2E);
                *(u32x4*)(pr + OFF_Q + ps * 512 + lane * 8) = pack8(f);
            }
#pragma unroll
            for (int ps = 0; ps < 2; ++ps) {
                const int c = ps * 512 + lane * 8;
                float f[8]; unpack8(in[2 + ps], f);
                qk_norm_rope(f, kg0, kg1, gl, cs, sn, 1.0f);
                float* ko = samp ? out + O_KS + (size_t)rs * 1024 + c : out + O_KP + (size_t)row * 1024 + c;
                *(f32x4*)ko = (f32x4){f[0], f[1], f[2], f[3]};
                *(f32x4*)(ko + 4) = (f32x4){f[4], f[5], f[6], f[7]};
                const u32x4 w = pack8(f);
                if (samp) *(u32x4*)((bf16_t*)(ws + WS_KS) + ((size_t)(rs >> 6) * 1088 + 1024 + (rs & 63)) * 1024 + c) = w;
                else *(u32x4*)(pr + OFF_K + c) = w;
            }
#pragma unroll
            for (int ps = 0; ps < 2; ++ps) {
                const int c = ps * 512 + lane * 8;
                const u32x4 w = in[4 + ps];
                float f[8]; unpack8(w, f);
                float* vo = samp ? out + O_VS + (size_t)rs * 1024 + c : out + O_VP + (size_t)row * 1024 + c;
                *(f32x4*)vo = (f32x4){f[0], f[1], f[2], f[3]};
                *(f32x4*)(vo + 4) = (f32x4){f[4], f[5], f[6], f[7]};
                if (samp) *(u32x4*)((bf16_t*)(ws + WS_VS) + ((size_t)(rs >> 6) * 1088 + 1024 + (rs & 63)) * 1024 + c) = w;
            }
            {
                float f[8]; unpack8(in[6], f);
#pragma unroll
                for (int i = 0; i < 8; ++i) f[i] = gelu_fast(f[i]);
                *(u32x4*)(pr + OFF_U + lane * 8) = pack8(f);
            }
            {
                const int c = lane * 8;
                float f[8]; unpack8(in[7], f);
                float sm = 0.f;
#pragma unroll
                for (int i = 0; i < 8; ++i) { f[i] = gelu_fast(f[i]); sm += f[i]; }
                const float mu = wave_sum(sm) * (1.0f / 512.0f);
                float q = 0.f;
#pragma unroll
                for (int i = 0; i < 8; ++i) { f[i] -= mu; q += f[i] * f[i]; }
                const float rstd = rsqrtf(wave_sum(q) * (1.0f / 512.0f) + EPS);
#pragma unroll
                for (int i = 0; i < 4; ++i) { f[i] = f[i] * rstd * lg0[i] + lb0[i]; f[4 + i] = f[4 + i] * rstd * lg1[i] + lb1[i]; }
                *(u32x4*)(pr + OFF_VC + c) = pack8(f);
                if (samp) {
                    float* co = out + O_CVS + (size_t)rs * 512 + c;
                    *(f32x4*)co = (f32x4){f[0], f[1], f[2], f[3]};
                    *(f32x4*)(co + 4) = (f32x4){f[4], f[5], f[6], f[7]};
                }
            }
            {
                float f[8]; unpack8(in[8], f);
                float ss = 0.f;
#pragma unroll
                for (int i = 0; i < 8; ++i) ss += f[i] * f[i];
                ss += shxf(ss, 1); ss += shxf(ss, 2); ss += shxf(ss, 4); ss += shxf(ss, 8);
                const float rstd = rsqrtf(ss * (1.0f / 128.0f) + EPS) * (0.08838834764831845f * LOG2E);
#pragma unroll
                for (int i = 0; i < 4; ++i) { f[i] = f[i] * rstd * mg0[i]; f[4 + i] = f[4 + i] * rstd * mg1[i]; }
                *(u32x4*)(pr + OFF_QM + lane * 8) = pack8(f);
            }
        } else {
            const int row = (job - J_TOK) * 4 + wave;
            const float* src = (const float*)(ws + WS_MEMKV) + (size_t)row * 1024;
            {
                const int c = lane * 8;
                const f32x4 a = *(const f32x4*)(src + c), b = *(const f32x4*)(src + c + 4);
                float f[8] = {a[0], a[1], a[2], a[3], b[0], b[1], b[2], b[3]};
                float ss = 0.f;
#pragma unroll
                for (int i = 0; i < 8; ++i) ss += f[i] * f[i];
                ss += shxf(ss, 1); ss += shxf(ss, 2); ss += shxf(ss, 4); ss += shxf(ss, 8);
                const float rstd = rsqrtf(ss * (1.0f / 128.0f) + EPS);
                const float* g = p.in[I_MKNG] + (lane & 15) * 8;
#pragma unroll
                for (int i = 0; i < 8; ++i) f[i] = f[i] * rstd * g[i];
                float* ko = out + O_MKP + (size_t)row * 512 + c;
                *(f32x4*)ko = (f32x4){f[0], f[1], f[2], f[3]};
                *(f32x4*)(ko + 4) = (f32x4){f[4], f[5], f[6], f[7]};
                *(u32x4*)((bf16_t*)(ws + WS_MEMKB) + (size_t)row * 512 + c) = pack8(f);
            }
            {
                const int c = lane * 8;
                const f32x4 a = *(const f32x4*)(src + 512 + c), b = *(const f32x4*)(src + 512 + c + 4);
                float f[8] = {a[0], a[1], a[2], a[3], b[0], b[1], b[2], b[3]};
                float* vo = out + O_MVP + (size_t)row * 512 + c;
                *(f32x4*)vo = a; *(f32x4*)(vo + 4) = b;
                *(u32x4*)((bf16_t*)(ws + WS_MEMVB) + (size_t)row * 512 + c) = pack8(f);
            }
        }
    }
}

template <int DQK, int KW, bool PF>
DI void attn_main(const bf16_t* Qw, int qstride, const bf16_t* Kg, size_t kstride, const bf16_t* Vg, size_t vstride, int nkt, int kcol, int vcol,
                  unsigned char* smem, f32x16 (&o)[4], float& m_run, float& l_run) {
    constexpr int KROW = KW * 2 + 16, VROW = KW * 2 + 32, VOFF = 64 * KROW, CPR = KW / 8, NCH = KW / 32, NKS = DQK / 16;
    const int tid = opaque_tid(), lane = tid & 63, r = lane & 31, h = lane >> 5;
    bf16x8 qf[NKS];
#pragma unroll
    for (int ks = 0; ks < NKS; ++ks) qf[ks] = *(const bf16x8*)(Qw + (size_t)r * qstride + ks * 16 + h * 8);
#pragma unroll
    for (int dt = 0; dt < 4; ++dt) o[dt] = zero16();
    m_run = -INFINITY; l_run = 0.f;
    u32x4 rk[NCH], rv[PF ? NCH : 1];
    constexpr int RPI = 256 / CPR;
    const unsigned kvo = (unsigned)((tid / CPR) * (int)kstride * 2 + (tid % CPR) * 16);
    const unsigned vvo = (unsigned)((tid / CPR) * (int)vstride * 2 + (tid % CPR) * 16);
    const int wlo = (tid / CPR) * KROW + (tid % CPR) * 16, wlv = VOFF + (tid / CPR) * VROW + (tid % CPR) * 16;
    if (PF) {
#pragma unroll
        for (int i = 0; i < NCH; ++i) { rk[i] = *(const u32x4*)((const char*)(Kg + (size_t)(i * RPI) * kstride) + kvo); rv[i] = *(const u32x4*)((const char*)(Vg + (size_t)(i * RPI) * vstride) + vvo); }
    }
    const int gi = lane >> 4, i16 = lane & 15, tq = i16 >> 2, tp = i16 & 3;
    const unsigned char* vbase = smem + VOFF + (4 * h + tq) * VROW + (vcol + 16 * (gi & 1)) * 2 + 8 * tp;
    const unsigned char* kbase = smem + r * KROW + (kcol + h * 8) * 2;
#pragma unroll 1
    for (int kt = 0; kt < nkt; ++kt) {
        if (!PF) {
#pragma unroll
            for (int i = 0; i < NCH; ++i) rk[i] = *(const u32x4*)((const char*)(Kg + (size_t)(kt * 64 + i * RPI) * kstride) + kvo);
        }
        __syncthreads();
        if (PF) {
#pragma unroll
            for (int i = 0; i < NCH; ++i) { *(u32x4*)(smem + wlo + i * RPI * KROW) = rk[i]; *(u32x4*)(smem + wlv + i * RPI * VROW) = rv[i]; }
        } else {
#pragma unroll
            for (int i = 0; i < NCH; ++i) *(u32x4*)(smem + wlo + i * RPI * KROW) = rk[i];
#pragma unroll
            for (int i = 0; i < NCH; ++i) rk[i] = *(const u32x4*)((const char*)(Vg + (size_t)(kt * 64 + i * RPI) * vstride) + vvo);
#pragma unroll
            for (int i = 0; i < NCH; ++i) *(u32x4*)(smem + wlv + i * RPI * VROW) = rk[i];
        }
        __syncthreads();
        if (PF && kt + 1 < nkt) {
#pragma unroll
            for (int i = 0; i < NCH; ++i) { rk[i] = *(const u32x4*)((const char*)(Kg + (size_t)((kt + 1) * 64 + i * RPI) * kstride) + kvo); rv[i] = *(const u32x4*)((const char*)(Vg + (size_t)((kt + 1) * 64 + i * RPI) * vstride) + vvo); }
        }
        f32x16 x[2];
#pragma unroll
        for (int mt = 0; mt < 2; ++mt) {
            bf16x8 kf[NKS];
#pragma unroll
            for (int ks = 0; ks < NKS; ++ks) kf[ks] = *(const bf16x8*)(kbase + mt * 32 * KROW + ks * 32);
            x[mt] = zero16();
#pragma unroll
            for (int ks = 0; ks < NKS; ++ks) x[mt] = MFMA32(kf[ks], qf[ks], x[mt]);
        }
        bf16x8 av[2][4];
#pragma unroll
        for (int f = 0; f < 4; ++f) { const int kb = 32 * (f >> 1) + 16 * (f & 1); av[0][f] = tr_pair(vbase + kb * VROW, vbase + (kb + 8) * VROW); }
        float mx = x[0][0];
#pragma unroll
        for (int mt = 0; mt < 2; ++mt)
#pragma unroll
            for (int i = 0; i < 16; ++i) mx = fmaxf(mx, x[mt][i]);
        mx = fmaxf(mx, shxf(mx, 32));
        const float mnew = fmaxf(m_run, mx);
        const float alpha = __builtin_amdgcn_exp2f(m_run - mnew);
        m_run = mnew;
        float psum = 0.f;
#pragma unroll
        for (int mt = 0; mt < 2; ++mt)
#pragma unroll
            for (int i = 0; i < 16; ++i) { x[mt][i] = __builtin_amdgcn_exp2f(x[mt][i] - mnew); psum += x[mt][i]; }
        l_run = l_run * alpha + psum;
#pragma unroll
        for (int dt = 0; dt < 4; ++dt) o[dt] = o[dt] * alpha;
        bf16x8 pb[2][2];
#pragma unroll
        for (int mt = 0; mt < 2; ++mt)
#pragma unroll
            for (int s = 0; s < 2; ++s) {
                u32x4 w;
                w.x = pk2(x[mt][8 * s + 0], x[mt][8 * s + 1]); w.y = pk2(x[mt][8 * s + 2], x[mt][8 * s + 3]);
                w.z = pk2(x[mt][8 * s + 4], x[mt][8 * s + 5]); w.w = pk2(x[mt][8 * s + 6], x[mt][8 * s + 7]);
                pb[mt][s] = __builtin_bit_cast(bf16x8, w);
            }
#pragma unroll
        for (int dt = 0; dt < 4; ++dt) {
            if (dt < 3) {
#pragma unroll
                for (int f = 0; f < 4; ++f) { const int kb = 32 * (f >> 1) + 16 * (f & 1); av[(dt + 1) & 1][f] = tr_pair(vbase + kb * VROW + (dt + 1) * 64, vbase + (kb + 8) * VROW + (dt + 1) * 64); }
            }
#pragma unroll
            for (int f = 0; f < 4; ++f) o[dt] = MFMA32(av[dt & 1][f], pb[f >> 1][f & 1], o[dt]);
        }
    }
}

DI void diff_item(const Params& p, unsigned char* smem, float lam, bool samp, int b, int hh, int c) {
    unsigned char* ws = p.ws;
    const bf16_t* P = (const bf16_t*)(ws + WS_P);
    const int tid = opaque_tid(), lane = tid & 63, wave = tid >> 6, r = lane & 31, h = lane >> 5;
    const int comp = wave >> 1, half = wave & 1;
    const int row0 = samp ? NP + b * 64 : b * 2048 + c * 64;
    const bf16_t* Qw = P + (size_t)(row0 + 32 * half) * INW + OFF_Q + hh * 128 + comp * 64;
    const bf16_t *Kg, *Vg; size_t kst; int nkt;
    if (samp) { Kg = (const bf16_t*)(ws + WS_KS) + (size_t)b * 1088 * 1024 + hh * 128; Vg = (const bf16_t*)(ws + WS_VS) + (size_t)b * 1088 * 1024 + hh * 128; kst = 1024; nkt = 17; }
    else { Kg = P + (size_t)b * 2048 * INW + OFF_K + hh * 128; Vg = P + (size_t)b * 2048 * INW + OFF_V + hh * 128; kst = INW; nkt = c + 1; }
    f32x16 o[4]; float m_run, l_run;
    attn_main<64, 128, true>(Qw, INW, Kg, kst, Vg, kst, nkt, comp * 64, 0, smem, o, m_run, l_run);
    const float inv = 1.0f / (l_run + shxf(l_run, 32));
    float* xch = (float*)smem;
    __syncthreads();
    if (comp == 1) {
#pragma unroll
        for (int dt = 0; dt < 4; ++dt)
#pragma unroll
            for (int ig = 0; ig < 4; ++ig) {
                f32x4 w = {o[dt][4 * ig] * inv, o[dt][4 * ig + 1] * inv, o[dt][4 * ig + 2] * inv, o[dt][4 * ig + 3] * inv};
                *(f32x4*)(xch + (32 * half + r) * 132 + 32 * dt + 8 * ig + 4 * h) = w;
            }
    }
    __syncthreads();
    if (comp == 0) {
        float ss = 0.f;
#pragma unroll
        for (int dt = 0; dt < 4; ++dt)
#pragma unroll
            for (int ig = 0; ig < 4; ++ig) {
                const f32x4 w = *(const f32x4*)(xch + (32 * half + r) * 132 + 32 * dt + 8 * ig + 4 * h);
#pragma unroll
                for (int j = 0; j < 4; ++j) { const float v = o[dt][4 * ig + j] * inv - lam * w[j]; o[dt][4 * ig + j] = v; ss += v * v; }
            }
        ss += shxf(ss, 32);
        const float rstd = rsqrtf(ss * (1.0f / 128.0f) + EPS) * 0.8f;
        bf16_t* mo = (bf16_t*)(ws + WS_MIXIN) + (size_t)(row0 + 32 * half + r) * D + hh * 128;
        const float* og = p.in[I_OUTG];
        f32x4 gq[4][4];
#pragma unroll
        for (int dt = 0; dt < 4; ++dt)
#pragma unroll
            for (int ig = 0; ig < 4; ++ig) gq[dt][ig] = *(const f32x4*)(og + 32 * dt + 8 * ig + 4 * h);
#pragma unroll
        for (int dt = 0; dt < 4; ++dt)
#pragma unroll
            for (int ig = 0; ig < 4; ++ig) {
                const int d0 = 32 * dt + 8 * ig + 4 * h;
                const f32x4 g = gq[dt][ig];
                u32x2 w; w.x = pk2(o[dt][4 * ig] * rstd * g[0], o[dt][4 * ig + 1] * rstd * g[1]); w.y = pk2(o[dt][4 * ig + 2] * rstd * g[2], o[dt][4 * ig + 3] * rstd * g[3]);
                *(u32x2*)(mo + d0) = w;
            }
    }
}

DI void mem_item(const Params& p, unsigned char* smem, int rt, int hp) {
    unsigned char* ws = p.ws;
    const bf16_t* P = (const bf16_t*)(ws + WS_P);
    const int tid = opaque_tid(), lane = tid & 63, wave = tid >> 6, r = lane & 31, h = lane >> 5;
    const int head = 2 * hp + (wave >> 1), half = wave & 1;
    const int row0 = rt * 64;
    const bf16_t *Kg, *Vg;
    if (rt < 128) { const int b = rt >> 5; Kg = (const bf16_t*)(ws + WS_MEMKB) + (size_t)b * 256 * 512 + hp * 256; Vg = (const bf16_t*)(ws + WS_MEMVB) + (size_t)b * 256 * 512 + hp * 256; }
    else { const int b = rt - 128; Kg = (const bf16_t*)(ws + WS_CMK) + (size_t)b * 256 * 512 + hp * 256; Vg = (const bf16_t*)(ws + WS_CMV) + (size_t)b * 256 * 512 + hp * 256; }
    const bf16_t* Qw = P + (size_t)(row0 + 32 * half) * INW + OFF_QM + head * 128;
    f32x16 o[4]; float m_run, l_run;
    attn_main<128, 256, false>(Qw, INW, Kg, 512, Vg, 512, 4, (wave >> 1) * 128, (wave >> 1) * 128, smem, o, m_run, l_run);
    const float inv = 1.0f / (l_run + shxf(l_run, 32));
    bf16_t* mo = (bf16_t*)(ws + WS_MIXIN) + (size_t)(row0 + 32 * half + r) * D + 1536 + head * 128;
#pragma unroll
    for (int dt = 0; dt < 4; ++dt)
#pragma unroll
        for (int ig = 0; ig < 4; ++ig) {
            const int d0 = 32 * dt + 8 * ig + 4 * h;
            u32x2 w; w.x = pk2(o[dt][4 * ig] * inv, o[dt][4 * ig + 1] * inv); w.y = pk2(o[dt][4 * ig + 2] * inv, o[dt][4 * ig + 3] * inv);
            *(u32x2*)(mo + d0) = w;
        }
}

DI void mlp_item(const Params& p, unsigned char* smem, int idx) {
    unsigned char* ws = p.ws;
    const bf16_t* P = (const bf16_t*)(ws + WS_P);
    const int tid = opaque_tid(), lane = tid & 63, wave = tid >> 6, r = lane & 31, h = lane >> 5;
    int row0, L, g;
    if (idx < 256) { const int b = idx >> 6, ch = (idx >> 2) & 15; g = idx & 3; row0 = b * 2048 + ch * 128; L = 128; }
    else { const int j = idx - 256; g = j & 3; row0 = NP + (j >> 2) * 64; L = 64; }
    constexpr int VROW = 288;
    __syncthreads();
    for (int c = tid; c < L * 16; c += 256) {
        const int s = c >> 4, cc = c & 15;
        *(u32x4*)(smem + s * VROW + cc * 16) = *(const u32x4*)(P + (size_t)(row0 + s) * INW + OFF_VC + g * 128 + cc * 8);
    }
    __syncthreads();
    if (32 * wave < L) {
        const int t = 32 * wave + r;
        const float* wsrow = p.in[I_CMWS] + ((size_t)g * 128 + t) * 128;
        f32x16 acc[4];
#pragma unroll
        for (int mt = 0; mt < 4; ++mt) acc[mt] = zero16();
        const int gi = lane >> 4, i16 = lane & 15, tq = i16 >> 2, tp = i16 & 3;
        const unsigned char* vbase = smem + (4 * h + tq) * VROW + (16 * (gi & 1)) * 2 + 8 * tp;
        const int nks = 2 * wave + 2;
        f32x4 wa[8], wb[8];
#pragma unroll
        for (int ks = 0; ks < 8; ++ks)
            if (ks < nks) { const int s0 = 16 * ks + 4 * h; wa[ks] = *(const f32x4*)(wsrow + s0); wb[ks] = *(const f32x4*)(wsrow + s0 + 8); }
#pragma unroll
        for (int ks = 0; ks < 8; ++ks)
            if (ks < nks) {
                const int s0 = 16 * ks + 4 * h;
                f32x4 w0 = wa[ks], w1 = wb[ks];
#pragma unroll
                for (int j = 0; j < 4; ++j) { if (s0 + j > t) w0[j] = 0.f; if (s0 + 8 + j > t) w1[j] = 0.f; }
                u32x4 bw; bw.x = pk2(w0[0], w0[1]); bw.y = pk2(w0[2], w0[3]); bw.z = pk2(w1[0], w1[1]); bw.w = pk2(w1[2], w1[3]);
                const bf16x8 bfrag = __builtin_bit_cast(bf16x8, bw);
#pragma unroll
                for (int mt = 0; mt < 4; ++mt) {
                    const bf16x8 a = tr_pair(vbase + (16 * ks) * VROW + mt * 64, vbase + (16 * ks + 8) * VROW + mt * 64);
                    acc[mt] = MFMA32(a, bfrag, acc[mt]);
                }
            }
        const float bias = p.in[I_CMBS][g * 128 + t];
        const bf16_t* up = P + (size_t)(row0 + t) * INW + OFF_U + g * 128;
        bf16_t* mo = (bf16_t*)(ws + WS_MIXIN) + (size_t)(row0 + t) * D + 1024 + g * 128;
        u32x2 uv[4][4];
#pragma unroll
        for (int mt = 0; mt < 4; ++mt)
#pragma unroll
            for (int ig = 0; ig < 4; ++ig) uv[mt][ig] = *(const u32x2*)(up + 32 * mt + 8 * ig + 4 * h);
#pragma unroll
        for (int mt = 0; mt < 4; ++mt)
#pragma unroll
            for (int ig = 0; ig < 4; ++ig) {
                const int c0 = 32 * mt + 8 * ig + 4 * h;
                const u32x2 u = uv[mt][ig];
                u32x2 w;
                w.x = pk2(bflo(u.x) * (acc[mt][4 * ig] + bias), bfhi(u.x) * (acc[mt][4 * ig + 1] + bias));
                w.y = pk2(bflo(u.y) * (acc[mt][4 * ig + 2] + bias), bfhi(u.y) * (acc[mt][4 * ig + 3] + bias));
                *(u32x2*)(mo + c0) = w;
            }
    }
}

DI void phase3(const Params& p, unsigned char* smem) {
    __shared__ int4 s_p3;
    int& s_item = s_p3.x;
    float& s_lam = *(float*)&s_p3.y;
    const int tid = threadIdx.x;
    if (tid < 64) {
        float a = p.in[I_LQ1][tid] * p.in[I_LK1][tid], b = p.in[I_LQ2][tid] * p.in[I_LK2][tid];
        a = wave_sum(a); b = wave_sum(b);
        if (tid == 0) s_lam = expf(a) - expf(b) + 0.2f;
    }
    __syncthreads();
    const float lam = s_lam;
    unsigned* ctr = (unsigned*)(p.ws + WS_CTL);
    constexpr int N_ATT = 1648, N_CONV = 1024, N_ITEMS = N_ATT + N_CONV;
    for (;;) {
        __syncthreads();
        if (tid == 0) s_item = (int)atomicAdd(ctr, 1u);
        __syncthreads();
        const int id = __builtin_amdgcn_readfirstlane(s_item);
        if (id >= N_ITEMS) break;
        int it;
        if (id < 2 * N_CONV) {
            if ((id & 1) == 0) {
                const int cj = (id >> 1) * 8;
#pragma unroll 1
                for (int q = 0; q < 8; ++q) {
                    const int j = cj + q;
                    if (j < 4096) convert_i4_rows(p.in[I_PU], p.ws + WS_UB, (float*)(p.ws + WS_USC), j);
                    else convert4_rows(p.in[I_PV], p.ws + WS_VB, (float*)(p.ws + WS_VSC), j - 4096);
                }
                continue;
            }
            it = id >> 1;
        } else it = id - N_CONV;
        if (it < 480) { diff_item(p, smem, lam, false, (it & 31) >> 3, it & 7, 31 - (it >> 5)); }
        else if (it < 544) { const int j = it - 480; diff_item(p, smem, lam, true, j >> 3, j & 7, 0); }
        else if (it < 832) { const int j = it - 544; diff_item(p, smem, lam, false, (j & 31) >> 3, j & 7, 16 - (j >> 5)); }
        else if (it < 1104) { const int j = it - 832; mem_item(p, smem, j >> 1, j & 1); }
        else if (it < 1392) { mlp_item(p, smem, it - 1104); }
        else { const int j = it - 1392; diff_item(p, smem, lam, false, (j & 31) >> 3, j & 7, 7 - (j >> 5)); }
    }
}

template <int MI> struct RingDepth { static constexpr int v = MI == 4 ? 3 : 4; };
template <int MI> DI void p4_tile(const Params& p, unsigned char* smem, int row0, int tn) {
    unsigned char* ws = p.ws;
    const bf16_t* mixin = (const bf16_t*)(ws + WS_MIXIN);
    const bf16_t* WbT = (const bf16_t*)(ws + WS_WBT);
    const bf16_t* P = (const bf16_t*)(ws + WS_P);
    bf16_t* merged = (bf16_t*)(ws + WS_MERGED);
    f32x16 tot[MI][2];
#pragma unroll
    for (int mi = 0; mi < MI; ++mi) tot[mi][0] = tot[mi][1] = zero16();
    const float* bgp = p.in[I_BGATE] + tn * 128;
    constexpr int GROW = 272;
#pragma unroll 1
    for (int seg = 0; seg < 3; ++seg) {
        const int k0 = seg == 0 ? 0 : (seg == 1 ? 1024 : 1536), nk = seg == 0 ? 32 : 16;
        f32x16 acc[MI][2];
#pragma unroll
        for (int mi = 0; mi < MI; ++mi) acc[mi][0] = acc[mi][1] = zero16();
        const int gtid = opaque_tid();
        const bf16_t* gsrc = P + (size_t)row0 * INW + OFF_G + seg * 2048 + tn * 128;
        u32x4 gv[MI * 4];
#pragma unroll
        for (int i = 0; i < MI * 4; ++i) { const int c = gtid + 256 * i; gv[i] = *(const u32x4*)(gsrc + (c >> 4) * INW + (c & 15) * 8); }
        gemm_kloop<MI, RingDepth<MI>::v>(acc, mixin + (size_t)row0 * D + k0, D, WbT + (size_t)tn * 128 * D + k0, D, nk, smem);
#pragma unroll
        for (int i = 0; i < MI * 4; ++i) { const int c = gtid + 256 * i; *(u32x4*)(smem + (c >> 4) * GROW + (c & 15) * 16) = gv[i]; }
        __syncthreads();
        const float* bseg = bgp + seg * 2048;
        EPI_FOR(MI, acc, {
            const float gl = bf2f(*(const bf16_t*)(smem + row * GROW + col * 2)) + bseg[col];
            const float gate = __builtin_amdgcn_rcpf(1.0f + __builtin_amdgcn_exp2f(gl * -LOG2E));
            tot[mi_][ni_][i_] += gate * v;
        })
        __syncthreads();
    }
    bf16_t* o = merged + (size_t)row0 * D + tn * 128;
    EPI_FOR(MI, tot, { o[row * D + col] = f2bf(v); })
}
DI void phase4(const Params& p, unsigned char* smem) {
    for_tiles(64, 16, [&](int tm, int tn) { p4_tile<2>(p, smem, tm * 128, tn); });
    for_tiles(8, 16, [&](int tm, int tn) { p4_tile<1>(p, smem, NP + tm * 64, tn); });
}

template <int MI> DI void p5_tile(const Params& p, unsigned char* smem, int row0, int tn) {
    unsigned char* ws = p.ws;
    const bf16_t* merged = (const bf16_t*)(ws + WS_MERGED);
    const bf16_t* WoT = (const bf16_t*)(ws + WS_WOT);
    bf16_t* x1g = (bf16_t*)(ws + WS_X1G);
    f32x16 acc[MI][2];
#pragma unroll
    for (int mi = 0; mi < MI; ++mi) acc[mi][0] = acc[mi][1] = zero16();
    gemm_kloop<MI, RingDepth<MI>::v>(acc, merged + (size_t)row0 * D, D, WoT + (size_t)tn * 128 * D, D, 64, smem);
    const float* xin = (row0 < NP ? p.in[I_XP] + (size_t)row0 * D : p.in[I_XS] + (size_t)(row0 - NP) * D) + tn * 128;
    float* y = p.out + O_Y + (size_t)row0 * D + tn * 128;
    bf16_t* xg = x1g + (size_t)row0 * D + tn * 128;
    const float* gfp = p.in[I_NFFNG] + tn * 128;
    {
        const int tid_ = opaque_tid(), lane_ = tid_ & 63, wave_ = tid_ >> 6, r_ = lane_ & 31, h_ = lane_ >> 5;
        const int rbase = (wave_ >> 1) * 32 * MI, cbase = (wave_ & 1) * 64 + r_;
        const float gc0 = gfp[cbase], gc1 = gfp[cbase + 32];
        float xv[2][16];
#pragma unroll
        for (int i = 0; i < 16; ++i) xv[0][i] = xin[(rbase + crow(i, h_)) * D + cbase];
#pragma unroll
        for (int st = 0; st < 2 * MI; ++st) {
            const int mi = st >> 1, ni = st & 1;
            if (st + 1 < 2 * MI) {
                const int mi2 = (st + 1) >> 1, ni2 = (st + 1) & 1;
#pragma unroll
                for (int i = 0; i < 16; ++i) xv[(st + 1) & 1][i] = xin[(rbase + mi2 * 32 + crow(i, h_)) * D + cbase + ni2 * 32];
            }
            const int col = cbase + ni * 32;
            const float gcol = ni == 0 ? gc0 : gc1;
#pragma unroll
            for (int i = 0; i < 16; ++i) {
                const int row = rbase + mi * 32 + crow(i, h_);
                const float x1 = xv[st & 1][i] + acc[mi][ni][i];
                y[row * D + col] = x1;
                xg[row * D + col] = f2bf(x1 * gcol);
            }
            asm volatile("" ::: "memory");
        }
    }
}
DI void phase5(const Params& p, unsigned char* smem) {
    for_tiles(32, 16, [&](int tm, int tn) { p5_tile<4>(p, smem, tm * 256, tn); });
    for_tiles(8, 16, [&](int tm, int tn) { p5_tile<1>(p, smem, NP + tm * 64, tn); });
}

DI void phase6(const Params& p, unsigned char* smem) {
    unsigned char* ws = p.ws;
    const bf16_t* x1g = (const bf16_t*)(ws + WS_X1G);
    const bf16_t* WqT = (const bf16_t*)(ws + WS_WQT);
    const bf16_t* SK = (const bf16_t*)(ws + WS_SKB);
    float* sc = (float*)(ws + WS_SCORES);
    constexpr int STAGE = 16384, A_BYTES = 8192;
    for_tiles(68, 16, [&](int tm, int tn) {
        f32x16 acc[2][2];
        acc[0][0] = acc[0][1] = acc[1][0] = acc[1][1] = zero16();
        gemm_kloop<2, 4>(acc, x1g + (size_t)tm * 128 * D, D, WqT + (size_t)tn * 128 * D, D, 64, smem);
        const int tid = opaque_tid(), lane = tid & 63, wave = tid >> 6, wm = wave >> 1, wn = wave & 1, r = lane & 31, h = lane >> 5;
        {
            const int frow = lane >> 2, fslot = lane & 3;
            const bf16_t* Bg = SK + (size_t)tn * 128 * 128;
#pragma unroll
            for (int sl = 0; sl < 4; ++sl)
#pragma unroll
                for (int i = 0; i < 2; ++i) {
                    const int R = (wave * 2 + i) * 16 + frow;
                    __builtin_amdgcn_global_load_lds((GLB1 const void*)(Bg + R * 128 + (fslot ^ ((R >> 2) & 3)) * 8 + sl * 32), (LDS3 void*)(smem + sl * STAGE + A_BYTES + (wave * 2 + i) * 1024), 16, 0, 0);
                }
        }
#pragma unroll
        for (int mi = 0; mi < 2; ++mi)
#pragma unroll
            for (int ni = 0; ni < 2; ++ni)
#pragma unroll
                for (int i = 0; i < 16; ++i) {
                    const int row = wm * 64 + mi * 32 + crow(i, h), k = wn * 64 + ni * 32 + r;
                    *(bf16_t*)(smem + (k >> 5) * STAGE + row * 64 + ((((k & 31) >> 3) ^ ((row >> 2) & 3)) * 16) + (k & 7) * 2) = f2bf(acc[mi][ni][i]);
                }
        asm volatile("s_waitcnt vmcnt(0)" ::: "memory");
        __syncthreads();
        f32x16 acc2[2][2];
        acc2[0][0] = acc2[0][1] = acc2[1][0] = acc2[1][1] = zero16();
        {
            const int sw = (r >> 2) & 3;
            const int a_rd = (wm * 64 + r) * 64, b_rd = A_BYTES + (wn * 64 + r) * 64;
#pragma unroll
            for (int sl = 0; sl < 4; ++sl)
#pragma unroll
                for (int ks = 0; ks < 2; ++ks) {
                    const unsigned char* st = smem + sl * STAGE;
                    const int ko = ((2 * ks + h) ^ sw) * 16;
                    const bf16x8 a0 = *(const bf16x8*)(st + a_rd + ko), a1 = *(const bf16x8*)(st + a_rd + 32 * 64 + ko);
                    const bf16x8 b0 = *(const bf16x8*)(st + b_rd + ko), b1 = *(const bf16x8*)(st + b_rd + 32 * 64 + ko);
                    acc2[0][0] = MFMA32(a0, b0, acc2[0][0]); acc2[0][1] = MFMA32(a0, b1, acc2[0][1]);
                    acc2[1][0] = MFMA32(a1, b0, acc2[1][0]); acc2[1][1] = MFMA32(a1, b1, acc2[1][1]);
                }
        }
        __syncthreads();
        float* o = sc + (size_t)tm * 128 * D + tn * 128;
        EPI_FOR(2, acc2, { o[row * D + col] = v; })
    });
}
DI void phase7(const Params& p, unsigned char* smem) {}

DI float dot2u(unsigned a, unsigned b, float acc) { return __builtin_amdgcn_fdot2_f32_bf16(__builtin_bit_cast(bf16v2, a), __builtin_bit_cast(bf16v2, b), acc, false); }
DI float dot8(u32x4 a, u32x4 b, float acc) {
    const unsigned a0 = a.x, a1 = a.y, a2 = a.z, a3 = a.w, b0 = b.x, b1 = b.y, b2 = b.z, b3 = b.w;
    acc = dot2u(a0, b0, acc); acc = dot2u(a1, b1, acc); acc = dot2u(a2, b2, acc); acc = dot2u(a3, b3, acc);
    return acc;
}
DI float rdl(float v, int i) { return __int_as_float(__builtin_amdgcn_readlane(__float_as_int(v), i)); }
DI int f2key(float f) { const int k = __float_as_int(f); return k ^ ((k >> 31) & 0x7fffffff); }
DI int imax(int a, int b) { return a > b ? a : b; }
DI int imin(int a, int b) { return a < b ? a : b; }
DI void bitonic128(int& a, int& b, int lane) {
#pragma unroll
    for (int k = 2; k <= 128; k <<= 1) {
#pragma unroll
        for (int j = k >> 1; j > 0; j >>= 1) {
            if (j == 64) { const int na = imax(a, b), nb = imin(a, b); a = na; b = nb; }
            else {
                const int pa = shx(a, j), pb = shx(b, j);
                const bool lowj = (lane & j) == 0;
                bool kma, kmb;
                if (k < 64) { kma = ((lane & k) == 0) == lowj; kmb = kma; }
                else if (k == 64) { kma = lowj; kmb = !lowj; }
                else { kma = lowj; kmb = lowj; }
                a = kma ? imax(a, pa) : imin(a, pa);
                b = kmb ? imax(b, pb) : imin(b, pb);
            }
        }
    }
}
DI void bitonic64(int& a, int lane) {
#pragma unroll
    for (int k = 2; k <= 64; k <<= 1) {
#pragma unroll
        for (int j = k >> 1; j > 0; j >>= 1) {
            const int pa = shx(a, j);
            const bool lowj = (lane & j) == 0;
            const bool km = (k < 64) ? (((lane & k) == 0) == lowj) : lowj;
            a = km ? imax(a, pa) : imin(a, pa);
        }
    }
}
DI void phase8(const Params& p, unsigned char* smem) {
    unsigned char* ws = p.ws;
    const int tid = threadIdx.x, lane = tid & 63, wave = tid >> 6;
    const bf16_t* x1g = (const bf16_t*)(ws + WS_X1G);
    const float* scores = (const float*)(ws + WS_SCORES);
    const unsigned char* Ub = ws + WS_UB;
    const float* usc = (const float*)(ws + WS_USC);
    const unsigned char* Vb = ws + WS_VB;
    const float* vsc = (const float*)(ws + WS_VSC);
    int ca = 0, cb = lane, cvalid = 0;
#pragma unroll
    for (int aa = 0; aa < 16; ++aa) { const int cnt = 16 / (aa + 1); if (!cvalid) { if (cb < cnt) { ca = aa; cvalid = 1; } else cb -= cnt; } }
    if (!cvalid) { ca = 0; cb = 0; }

    int* wge = (int*)(smem + wave * 1024);
    float* wgg = (float*)(smem + wave * 1024 + 512);
    for (int t = blockIdx.x * 4 + wave; t < MT; t += gridDim.x * 4) {
        float* yrow = p.out + O_Y + (size_t)t * D;
        float ss = 0.f;
#pragma unroll
        for (int c = 0; c < 2; ++c)
#pragma unroll
            for (int q = 0; q < 4; ++q) { const f32x4 xv = *(const f32x4*)(yrow + c * 1024 + lane * 16 + 4 * q); ss += xv[0] * xv[0] + xv[1] * xv[1] + xv[2] * xv[2] + xv[3] * xv[3]; }
        const float rstd = rsqrtf(wave_sum(ss) * (1.0f / 2048.0f) + EPS);
        unsigned hq1[2][2], hq2[2][2];
        float hs1, hs2;
        {
            float hf[2][16];
            float am = 0.f;
#pragma unroll
            for (int c = 0; c < 2; ++c) {
                const u32x4 h0 = *(const u32x4*)(x1g + (size_t)t * D + c * 1024 + lane * 16), h1 = *(const u32x4*)(x1g + (size_t)t * D + c * 1024 + lane * 16 + 8);
                unpack8(h0, &hf[c][0]); unpack8(h1, &hf[c][8]);
#pragma unroll
                for (int j = 0; j < 16; ++j) am = fmaxf(am, fabsf(hf[c][j]));
            }
#pragma unroll
            for (int o = 32; o > 0; o >>= 1) am = fmaxf(am, shxf(am, o));
            hs1 = am > 0.f ? am * (1.0f / 7.0f) : 1.0f; hs2 = hs1 * (1.0f / 14.0f);
            const float i1 = 1.0f / hs1, i2 = 1.0f / hs2;
#pragma unroll
            for (int c = 0; c < 2; ++c)
#pragma unroll
                for (int d = 0; d < 2; ++d) {
                    unsigned a = 0, b = 0;
#pragma unroll
                    for (int j = 0; j < 8; ++j) {
                        const float x = hf[c][8 * d + j];
                        const float q1 = fminf(fmaxf(rintf(x * i1), -7.0f), 7.0f);
                        const float q2 = fminf(fmaxf(rintf((x - q1 * hs1) * i2), -7.0f), 7.0f);
                        a |= ((unsigned)(int)q1 & 0xFu) << (4 * j); b |= ((unsigned)(int)q2 & 0xFu) << (4 * j);
                    }
                    hq1[c][d] = a; hq2[c][d] = b;
                }
        }
#pragma unroll 1
        for (int hp = 0; hp < 4; ++hp) {
#pragma unroll
            for (int hh = 0; hh < 2; ++hh) {
                const float* sc = scores + (size_t)t * D + (hp * 2 + hh) * 256;
                const float v0a = sc[lane], v0b = sc[64 + lane], v1a = sc[128 + lane], v1b = sc[192 + lane];
                int k0a = (f2key(v0a) & ~127) | (127 - lane), k0b = (f2key(v0b) & ~127) | (63 - lane);
                int k1a = (f2key(v1a) & ~127) | (127 - lane), k1b = (f2key(v1b) & ~127) | (63 - lane);
                bitonic128(k0a, k0b, lane);
                bitonic128(k1a, k1b, lane);
                const int i0 = 127 - (k0a & 127), i1 = 127 - (k1a & 127);
                const float s0a = __shfl(v0a, i0 & 63), s0b = __shfl(v0b, i0 & 63), s1a = __shfl(v1a, i1 & 63), s1b = __shfl(v1b, i1 & 63);
                const float s0 = (i0 & 64) ? s0b : s0a, s1 = (i1 & 64) ? s1b : s1a;
                const float cval = __shfl(s0, ca) + __shfl(s1, cb);
                const int cexp = __shfl(i0, ca) * 128 + __shfl(i1, cb);
                int ck = cvalid ? ((f2key(cval) & ~63) | (63 - lane)) : (int)0x80000000;
                bitonic64(ck, lane);
                const int src = 63 - (ck & 63);
                const float tv = __shfl(cval, src);
                const int te = __shfl(cexp, src);
                const float mx = rdl(tv, 0);
                const float ew = lane < 16 ? __expf(rstd * (tv - mx)) : 0.f;
                float sum = ew;
                sum += shxf(sum, 8); sum += shxf(sum, 4); sum += shxf(sum, 2); sum += shxf(sum, 1);
                if (lane < 16) { wge[(hp * 2 + hh) * 16 + lane] = te; wgg[(hp * 2 + hh) * 16 + lane] = ew / sum; }
            }
        }
        f32x2 oacc2[2][8];
#pragma unroll
        for (int c = 0; c < 2; ++c)
#pragma unroll
            for (int j = 0; j < 8; ++j) oacc2[c][j] = (f32x2){0.f, 0.f};
#define PEER_LOAD(e_, ex_, gx_, us_, uu_, vv_)                                                                                   \
        {                                                                                                                   \
            _Pragma("unroll") for (int k = 0; k < 4; ++k) { ex_[k] = __builtin_amdgcn_readfirstlane(wge[(e_) + k]); gx_[k] = wgg[(e_) + k]; } \
            _Pragma("unroll") for (int k = 0; k < 4; ++k) { gx_[k] *= vsc[ex_[k]]; us_[k] = usc[ex_[k]]; }                \
            _Pragma("unroll") for (int k = 0; k < 4; ++k) _Pragma("unroll") for (int c = 0; c < 2; ++c)                     \
                uu_[k][c] = *(const u32x2*)(Ub + (size_t)ex_[k] * 1024 + c * 512 + lane * 8);                                \
            _Pragma("unroll") for (int k = 0; k < 4; ++k) _Pragma("unroll") for (int c = 0; c < 2; ++c)                     \
                vv_[k][c] = *(const u32x2*)(Vb + (size_t)ex_[k] * 1024 + c * 512 + lane * 8);                                \
        }
#define PEER_COMPUTE(ex_, gx_, us_, uu_, vv_)                                                                                    \
        {                                                                                                                   \
            float dd[4];                                                                                                    \
            _Pragma("unroll") for (int k = 0; k < 4; ++k) {                                                                 \
                int i1 = 0, i2 = 0;                                                                                         \
                _Pragma("unroll") for (int c = 0; c < 2; ++c) _Pragma("unroll") for (int q = 0; q < 2; ++q) {               \
                    const int w = (int)uu_[k][c][q];                                                                        \
                    i1 = __builtin_amdgcn_sdot8(w, (int)hq1[c][q], i1, false); i2 = __builtin_amdgcn_sdot8(w, (int)hq2[c][q], i2, false); \
                }                                                                                                           \
                dd[k] = (hs1 * (float)i1 + hs2 * (float)i2) * us_[k];                                                       \
                __builtin_amdgcn_sched_barrier(0);                    \
            }                                                                                                               \
            _Pragma("unroll") for (int o = 32; o > 0; o >>= 1) { _Pragma("unroll") for (int k = 0; k < 4; ++k) dd[k] += shxf(dd[k], o); } \
            _Pragma("unroll") for (int k = 0; k < 4; ++k) {                                                                 \
                const float aa = gx_[k] * gelu_fast(dd[k] * rstd);                                                   \
                const f32x2 ab = {aa, aa};                                                                                  \
                _Pragma("unroll") for (int c = 0; c < 2; ++c) _Pragma("unroll") for (int q = 0; q < 2; ++q) {               \
                    const unsigned w = vv_[k][c][q];                                                                        \
                    const f32x2 e0 = __builtin_amdgcn_cvt_scalef32_pk_f32_fp4(w, 1.0f, 0), e1 = __builtin_amdgcn_cvt_scalef32_pk_f32_fp4(w, 1.0f, 1); \
                    const f32x2 e2 = __builtin_amdgcn_cvt_scalef32_pk_f32_fp4(w, 1.0f, 2), e3 = __builtin_amdgcn_cvt_scalef32_pk_f32_fp4(w, 1.0f, 3); \
                    oacc2[c][4 * q] = ab * e0 + oacc2[c][4 * q]; oacc2[c][4 * q + 1] = ab * e1 + oacc2[c][4 * q + 1];       \
                    oacc2[c][4 * q + 2] = ab * e2 + oacc2[c][4 * q + 2]; oacc2[c][4 * q + 3] = ab * e3 + oacc2[c][4 * q + 3]; \
                }                                                                                                           \
                __builtin_amdgcn_sched_barrier(0);                                                                          \
            }                                                                                                               \
        }
        {
            int exA[4], exB[4]; float gxA[4], gxB[4], usA[4], usB[4];
            u32x2 uuA[4][2], uuB[4][2], vvA[4][2], vvB[4][2];
            PEER_LOAD(0, exA, gxA, usA, uuA, vvA)
#pragma unroll 1
            for (int e = 0; e < 128; e += 8) {
                PEER_LOAD(e + 4, exB, gxB, usB, uuB, vvB)
                PEER_COMPUTE(exA, gxA, usA, uuA, vvA)
                if (e + 8 < 128) PEER_LOAD(e + 8, exA, gxA, usA, uuA, vvA)
                PEER_COMPUTE(exB, gxB, usB, uuB, vvB)
            }
        }
#undef PEER_LOAD
#undef PEER_COMPUTE
        f32x4 xr[2][4];
#pragma unroll
        for (int c = 0; c < 2; ++c)
#pragma unroll
            for (int q = 0; q < 4; ++q) xr[c][q] = *(const f32x4*)(yrow + c * 1024 + lane * 16 + 4 * q);
#pragma unroll
        for (int c = 0; c < 2; ++c)
#pragma unroll
            for (int q = 0; q < 4; ++q) {
                f32x4 xv = xr[c][q];
                xv[0] += oacc2[c][2 * q][0]; xv[1] += oacc2[c][2 * q][1]; xv[2] += oacc2[c][2 * q + 1][0]; xv[3] += oacc2[c][2 * q + 1][1];
                *(f32x4*)(yrow + c * 1024 + lane * 16 + 4 * q) = xv;
            }
    }
}

#define XB_TMO      128
#define XB_XCNT(j)  (256  + 64 * (j))
#define XB_XSUB(j)  (1280 + 64 * (j))
#define XB_XGEN(j)  (2304 + 64 * (j))
#define XB_TOP      3328
#define XB_TOPGEN   3392
#define XCD_BAR_WORDS 3456
#define XB_SPIN_CAP (1u << 18)
DI unsigned xb_ld(unsigned* p) { return __hip_atomic_load(p, __ATOMIC_RELAXED, __HIP_MEMORY_SCOPE_AGENT); }
DI unsigned xb_add(unsigned* p, unsigned v) { return __hip_atomic_fetch_add(p, v, __ATOMIC_RELAXED, __HIP_MEMORY_SCOPE_AGENT); }
DI unsigned xb_xcc_id() { return (unsigned)__builtin_amdgcn_s_getreg((3 << 11) | 20) & 0xFu; }
#define XB_SPIN(cond, bar) do { unsigned _sp = 0; while (cond) { __builtin_amdgcn_s_sleep(1); \
    if ((++_sp & 255u) == 0u) { if (xb_ld(&(bar)[XB_TMO])) break; if (_sp > XB_SPIN_CAP) { atomicAdd(&(bar)[XB_TMO], 1u); break; } } } } while (0)
struct XcdBarrier { unsigned* bar; unsigned x; volatile LDS3 unsigned* st; };
DI XcdBarrier xcd_barrier_post(unsigned* bar, volatile LDS3 unsigned* st) {
    XcdBarrier b; b.bar = bar; b.x = xb_xcc_id(); b.st = st;
    if (threadIdx.x == 0) (void)xb_add(&bar[XB_XCNT(b.x)], 1u);
    return b;
}
DI void xcd_barrier_complete(unsigned* bar, unsigned x, unsigned& nloc, unsigned& nx) {
    const unsigned G = gridDim.x * gridDim.y * gridDim.z;
    unsigned sum, cnt, mine, sp = 0u;
    for (;;) {
        sum = 0u; cnt = 0u; mine = 0u;
#pragma unroll
        for (unsigned j = 0; j < 16; ++j) { const unsigned c = xb_ld(&bar[XB_XCNT(j)]); sum += c; cnt += (c > 0u) ? 1u : 0u; mine = (j == x) ? c : mine; }
        if (sum == G) break;
        __builtin_amdgcn_s_sleep(1);
        if ((++sp & 255u) == 0u) { if (xb_ld(&bar[XB_TMO])) break; if (sp > XB_SPIN_CAP) { atomicAdd(&bar[XB_TMO], 1u); break; } }
    }
    nloc = mine > 0u ? mine : 1u; nx = cnt > 0u ? cnt : 1u;
}
DI void xcd_barrier(const XcdBarrier& b) {
    asm volatile("s_waitcnt vmcnt(0)" ::: "memory");
    __syncthreads();
    if (threadIdx.x == 0) {
        unsigned* bar = b.bar;
        __builtin_amdgcn_s_waitcnt(0);
        unsigned nloc = b.st[0], nx = b.st[1];
        if (nloc == 0u) { xcd_barrier_complete(bar, b.x, nloc, nx); b.st[0] = nloc; b.st[1] = nx; }
        const unsigned old = xb_add(&bar[XB_XSUB(b.x)], 1u);
        const unsigned gen = old / nloc;
        if (old + 1u == (gen + 1u) * nloc) {
            __builtin_amdgcn_fence(__ATOMIC_RELEASE, "agent");
            asm volatile("s_waitcnt vmcnt(0)" ::: "memory");
            const unsigned og = xb_add(&bar[XB_TOP], 1u);
            const unsigned tg = og / nx;
            if (og + 1u == (tg + 1u) * nx) xb_add(&bar[XB_TOPGEN], 1u);
            else XB_SPIN(xb_ld(&bar[XB_TOPGEN]) == tg, bar);
            __builtin_amdgcn_fence(__ATOMIC_ACQUIRE, "agent");
            xb_add(&bar[XB_XGEN(b.x)], 1u);
            asm volatile("s_waitcnt vmcnt(0)" ::: "memory");
        } else {
            XB_SPIN(xb_ld(&bar[XB_XGEN(b.x)]) == gen, bar);
            __builtin_amdgcn_fence(__ATOMIC_ACQUIRE, "agent");
            asm volatile("s_waitcnt vmcnt(0)" ::: "memory");
        }
    }
    __syncthreads();
}

__global__ void __launch_bounds__(256, 2) mega(Params p, int ph_lo, int ph_hi, int coop) {
    extern __shared__ __attribute__((aligned(16))) unsigned char smem[];
    __shared__ uint4 xb_words;
    if (threadIdx.x == 0) xb_words = make_uint4(0u, 0u, 0u, 0u);
    __syncthreads();
    XcdBarrier xb;
    xb.bar = nullptr; xb.x = 0; xb.st = nullptr;
    if (coop) xb = xcd_barrier_post((unsigned*)(p.ws + WS_BAR), (volatile LDS3 unsigned*)&xb_words);
    if (coop == 2) cg::this_grid().sync();
#define RUN_PHASE(k, fn)                                              \
    if (ph_lo <= (k) && (k) < ph_hi) {                                  \
        fn(p, smem);                                                    \
        if (coop && (k) + 1 < ph_hi) xcd_barrier(xb);                   \
    }
    RUN_PHASE(0, phase0)
    RUN_PHASE(1, phase1)
    RUN_PHASE(2, phase2)
    RUN_PHASE(3, phase3)
    RUN_PHASE(4, phase4)
    RUN_PHASE(5, phase5)
    RUN_PHASE(6, phase6)
    RUN_PHASE(8, phase8)
}

#ifndef N_LAUNCH_MODE
#define N_LAUNCH_MODE 1
#endif

extern "C" void kernel_launch(void* const* d_in, const int* in_sizes, int n_in, void* d_out, int out_size, void* d_ws, size_t ws_size, hipStream_t stream) {
    static int grid = 0;
    if (grid == 0) {
        int dev = 0, cus = 0, per_cu = 0;
        hipGetDevice(&dev);
        hipDeviceGetAttribute(&cus, hipDeviceAttributeMultiprocessorCount, dev);
        hipFuncSetAttribute((const void*)mega, hipFuncAttributeMaxDynamicSharedMemorySize, LDS_BYTES);
        hipOccupancyMaxActiveBlocksPerMultiprocessor(&per_cu, (const void*)mega, 256, LDS_BYTES);
        if (per_cu < 1) per_cu = 1;
        if (per_cu > 2) per_cu = 2;
        grid = cus * per_cu;
        if (n_in != 32 || ws_size < WS_END) { fprintf(stderr, "kernel_launch: unexpected n_in %d / ws_size %zu (need %zu)\n", n_in, ws_size, (size_t)WS_END); grid = -1; }
    }
    if (grid < 0) return;
    Params p{};
    for (int i = 0; i < 32; ++i) p.in[i] = (const float*)d_in[i];
    p.out = (float*)d_out;
    p.ws = (unsigned char*)d_ws;
    hipMemsetAsync((char*)d_ws + WS_CTL, 0, 32768, stream);
#if N_LAUNCH_MODE == 1
    int lo = 0, hi = 9, coop = 1;
    void* args[] = {&p, &lo, &hi, &coop};
    hipError_t e = hipLaunchCooperativeKernel((const void*)mega, dim3(grid), dim3(256), args, LDS_BYTES, stream);
    if (e != hipSuccess) fprintf(stderr, "cooperative launch failed: %s (grid %d)\n", hipGetErrorString(e), grid);
#else
    for (int ph = 0; ph < 9; ++ph) hipLaunchKernelGGL(mega, dim3(grid), dim3(256), LDS_BYTES, stream, p, ph, ph + 1, 0);
#endif
}
```
